# Optimizing an MI355X kernel written in HIP

```python
import math, functools
import jax, jax.numpy as jnp
from jax import lax
import numpy as np

D_MODEL = 1024
BATCH = 8
SEQ = 2048
DEPTH = 2

GRID_W = 64
CTX_LEN = 256
HEAD_DIM = 64
N_BRANCH = 4
BRANCH_W = D_MODEL // 2
NA_HEADS = BRANCH_W // HEAD_DIM
NA_WIN_R = 8
NA_WIN_C = 16
RET_HEADS = BRANCH_W // (2 * HEAD_DIM)
RET_DK = HEAD_DIM
RET_DV = 2 * HEAD_DIM
RET_CHUNK = 128
DIFF_HEADS = BRANCH_W // (2 * HEAD_DIM)
DIFF_DK = HEAD_DIM
DIFF_DV = 2 * HEAD_DIM
DIFF_BLOCK = 128
DN_HEADS = BRANCH_W // (2 * HEAD_DIM)
DN_DK = HEAD_DIM
DN_DV = 2 * HEAD_DIM
DN_CONV = 5
DN_CHUNK = 64
DN_CONV_CH = 2 * DN_HEADS * DN_DK + DN_HEADS * DN_DV
N_EXPERTS = 32
TOP_K = 4
D_FF = D_MODEL
SWIGLU_LIMIT = 7.0
SWIGLU_ALPHA = 1.702
MOE_BLOCK = 128
ROPE_BASE = 10000.0
EPS = 1e-6
IN_SPLITS = (
    NA_HEADS * HEAD_DIM, NA_HEADS * HEAD_DIM, NA_HEADS * HEAD_DIM,
    RET_HEADS * RET_DK, RET_HEADS * RET_DK, RET_HEADS * RET_DV, BRANCH_W,
    DIFF_HEADS * 2 * DIFF_DK, DIFF_HEADS * 2 * DIFF_DK, DIFF_HEADS * DIFF_DV,
    DN_HEADS * DN_DK, DN_HEADS * DN_DK, DN_HEADS * DN_DV, BRANCH_W, 2 * DN_HEADS, 2 * DN_HEADS,
)
D_IN = sum(IN_SPLITS)
F32 = jnp.float32

kernel_name = 'hybrid_na_ret_diff_gdn_moe_dit'


def rms_norm(x, g):
    xf = x.astype(F32)
    y = xf * lax.rsqrt(jnp.mean(xf * xf, axis=-1, keepdims=True) + EPS)
    return (y * g.astype(F32)).astype(x.dtype)


def head_layer_norm(x, g):
    xf = x.astype(F32)
    xc = xf - jnp.mean(xf, axis=-1, keepdims=True)
    return xc * lax.rsqrt(jnp.mean(xc * xc, axis=-1, keepdims=True) + EPS) * g.astype(F32)


def l2_normalize(t):
    tf = t.astype(F32)
    return tf * lax.rsqrt(jnp.sum(tf * tf, axis=-1, keepdims=True) + EPS)


def modulate(h, shift, scale):
    return h * (1.0 + scale) + shift


def rope_angles(pos, dim):
    inv = ROPE_BASE ** (-jnp.arange(0, dim, 2, dtype=F32) / dim)
    return pos.astype(F32)[:, None] * inv[None, :]


def apply_rope(x, ang):
    half = x.shape[-1] // 2
    shape = (x.shape[1],) + (1,) * (x.ndim - 3) + (half,)
    cos = jnp.cos(ang).reshape(shape).astype(x.dtype)
    sin = jnp.sin(ang).reshape(shape).astype(x.dtype)
    x1, x2 = x[..., :half], x[..., half:]
    return jnp.concatenate([x1 * cos - x2 * sin, x2 * cos + x1 * sin], axis=-1)


def axial_rope(x, ang_row, ang_col):
    half = x.shape[-1] // 2
    return jnp.concatenate([apply_rope(x[..., :half], ang_row), apply_rope(x[..., half:], ang_col)], axis=-1)


def prefix_scan(scan_fn, ctx_seq, lat_seq, s0, reverse):
    if reverse:
        ctx_seq = tuple(jnp.flip(t, 1) for t in ctx_seq)
        lat_seq = tuple(jnp.flip(t, 1) for t in lat_seq)
    o_ctx, s_ctx = scan_fn(*ctx_seq, s0)
    o_lat, _ = scan_fn(*lat_seq, s_ctx)
    if reverse:
        o_ctx, o_lat = jnp.flip(o_ctx, 1), jnp.flip(o_lat, 1)
    return jnp.concatenate([o_ctx, o_lat], axis=1)


def short_conv(t, w):
    return lax.conv_general_dilated(t, w[:, None, :].astype(t.dtype), window_strides=(1,),
                                    padding=[(DN_CONV // 2, DN_CONV // 2)],
                                    dimension_numbers=('NWC', 'WIO', 'NWC'),
                                    feature_group_count=t.shape[-1])


def neighbourhood_branch(q, k, v, n_ctx, qk_gain, rpb):
    B, L, _ = q.shape
    H, d = NA_HEADS, HEAD_DIM
    q = rms_norm(q.reshape(B, L, H, d), qk_gain[0])
    k = rms_norm(k.reshape(B, L, H, d), qk_gain[1])
    v = v.reshape(B, L, H, d)
    qc, kc, vc = q[:, :n_ctx], k[:, :n_ctx], v[:, :n_ctx]
    S = L - n_ctx
    rows = S // GRID_W
    win_r = min(NA_WIN_R, rows)
    n_nb = win_r * NA_WIN_C
    scale = d ** -0.5
    s_cc = jnp.einsum('bqhd,bkhd->bhqk', qc, kc).astype(F32) * scale
    o_ctx = jnp.einsum('bhqk,bkhd->bqhd', jax.nn.softmax(s_cc, axis=-1).astype(v.dtype), vc)
    qg = q[:, n_ctx:].reshape(B, rows, GRID_W, H, d)
    kg = k[:, n_ctx:].reshape(B, rows, GRID_W, H, d)
    vg = v[:, n_ctx:].reshape(B, rows, GRID_W, H, d)
    col = np.arange(GRID_W)
    cols = np.clip(col - NA_WIN_C // 2, 0, GRID_W - NA_WIN_C)[:, None] + np.arange(NA_WIN_C)[None, :]
    dc_idx = jnp.asarray(cols - col[:, None] + NA_WIN_C - 1)

    def row_block(r):
        r0 = jnp.clip(r - win_r // 2, 0, rows - win_r)
        kn = lax.dynamic_slice_in_dim(kg, r0, win_r, axis=1)[:, :, cols]
        vn = lax.dynamic_slice_in_dim(vg, r0, win_r, axis=1)[:, :, cols]
        qr = lax.dynamic_index_in_dim(qg, r, axis=1, keepdims=False)
        dr_idx = r0 + jnp.arange(win_r) - r + NA_WIN_R - 1
        bias = rpb[:, dr_idx[None, :, None], dc_idx[:, None, :]].astype(F32)
        s_nb = jnp.einsum('bqhd,biqjhd->bhqij', qr, kn).astype(F32) * scale + bias
        s_ctx = jnp.einsum('bqhd,bkhd->bhqk', qr, kc).astype(F32) * scale
        p = jax.nn.softmax(jnp.concatenate([s_nb.reshape(B, H, GRID_W, n_nb), s_ctx], axis=-1), axis=-1).astype(v.dtype)
        p_nb = p[..., :n_nb].reshape(B, H, GRID_W, win_r, NA_WIN_C)
        return (jnp.einsum('bhqij,biqjhd->bqhd', p_nb, vn)
                + jnp.einsum('bhqk,bkhd->bqhd', p[..., n_nb:], vc))

    o_lat = jnp.moveaxis(lax.map(row_block, jnp.arange(rows)), 0, 1).reshape(B, S, H, d)
    return jnp.concatenate([o_ctx, o_lat], axis=1).reshape(B, L, H * d)


def retention_chunked(q, k, v, s0, log_g):
    B, L, H, _ = q.shape
    dv = v.shape[-1]
    c = RET_CHUNK
    n = L // c
    pos = jnp.arange(c, dtype=F32)
    rel = pos[:, None] - pos[None, :]
    intra = jnp.where(rel >= 0, jnp.exp(log_g[:, None, None] * jnp.maximum(rel, 0.0)), 0.0)
    q_dec = jnp.exp(log_g[None, :] * (pos[:, None] + 1.0))
    k_dec = jnp.exp(log_g[None, :] * (c - 1.0 - pos[:, None]))
    c_dec = jnp.exp(log_g * c)

    def to_chunks(t):
        return jnp.moveaxis(t.astype(F32).reshape(B, n, c, H, t.shape[-1]), 1, 0)

    def step(s, inp):
        qi, ki, vi = inp
        att = jnp.einsum('bihd,bjhd->bhij', qi, ki) * intra
        o = (jnp.einsum('bhij,bjhe->bihe', att, vi)
             + jnp.einsum('bihd,bhde->bihe', qi * q_dec[:, :, None], s))
        s = s * c_dec[:, None, None] + jnp.einsum('bjhd,bjhe->bhde', ki * k_dec[:, :, None], vi)
        return s, o

    s, o = lax.scan(step, s0.astype(F32), (to_chunks(q), to_chunks(k), to_chunks(v)))
    return jnp.moveaxis(o, 0, 1).reshape(B, L, H, dv), s


def retention_branch(q, k, v, gate, n_ctx, ang_t, decay, gn_gain):
    B, L, _ = q.shape
    H = RET_HEADS
    q = q.reshape(B, L, H, RET_DK)
    k = k.reshape(B, L, H, RET_DK)
    v = v.reshape(B, L, H, RET_DV)
    q = jnp.concatenate([q[:, :n_ctx], apply_rope(q[:, n_ctx:], ang_t)], axis=1)
    k = jnp.concatenate([k[:, :n_ctx], apply_rope(k[:, n_ctx:], ang_t)], axis=1) * (RET_DK ** -0.5)
    log_g = jax.nn.log_sigmoid(decay.astype(F32))
    s0 = jnp.zeros((B, H, RET_DK, RET_DV), F32)
    ctx_seq = (q[:, :n_ctx], k[:, :n_ctx], v[:, :n_ctx])
    lat_seq = (q[:, n_ctx:], k[:, n_ctx:], v[:, n_ctx:])
    y_fwd = prefix_scan(functools.partial(retention_chunked, log_g=log_g[0]), ctx_seq, lat_seq, s0, False)
    y_bwd = prefix_scan(functools.partial(retention_chunked, log_g=log_g[1]), ctx_seq, lat_seq, s0, True)
    y = head_layer_norm(y_fwd + y_bwd, gn_gain) * jax.nn.silu(gate.astype(F32)).reshape(B, L, H, RET_DV)
    return y.reshape(B, L, H * RET_DV).astype(gate.dtype)


def diff_branch(q, k, v, n_ctx, ang_r, ang_c, qk_gain, lam_p, subln_gain, lam_init):
    B, L, _ = q.shape
    H = DIFF_HEADS
    q = rms_norm(q.reshape(B, L, H, 2, DIFF_DK), qk_gain[0])
    k = rms_norm(k.reshape(B, L, H, 2, DIFF_DK), qk_gain[1])
    q = jnp.concatenate([q[:, :n_ctx], axial_rope(q[:, n_ctx:], ang_r, ang_c)], axis=1)
    k = jnp.concatenate([k[:, :n_ctx], axial_rope(k[:, n_ctx:], ang_r, ang_c)], axis=1)
    v = v.reshape(B, L, H, DIFF_DV)
    lp = lam_p.astype(F32)
    lam = jnp.exp(jnp.sum(lp[0] * lp[1])) - jnp.exp(jnp.sum(lp[2] * lp[3])) + lam_init
    scale = DIFF_DK ** -0.5

    def attend(qb, kb, vb):
        s = jnp.einsum('bqhcd,bkhcd->bhcqk', qb, kb).astype(F32) * scale
        p = jax.nn.softmax(s, axis=-1)
        a = (p[:, :, 0] - lam * p[:, :, 1]).astype(vb.dtype)
        return jnp.einsum('bhqk,bkhe->bqhe', a, vb)

    o_ctx = attend(q[:, :n_ctx], k[:, :n_ctx], v[:, :n_ctx])
    S = L - n_ctx
    qb = jnp.moveaxis(q[:, n_ctx:].reshape(B, S // DIFF_BLOCK, DIFF_BLOCK, H, 2, DIFF_DK), 1, 0)
    o_lat = jnp.moveaxis(lax.map(lambda qq: attend(qq, k, v), qb), 0, 1).reshape(B, S, H, DIFF_DV)
    o = rms_norm(jnp.concatenate([o_ctx, o_lat], axis=1), subln_gain) * (1.0 - lam_init)
    return o.reshape(B, L, H * DIFF_DV)


def gated_delta_chunked(q, k, v, g, beta, s0):
    B, L, H, _ = q.shape
    dv = v.shape[-1]
    c = DN_CHUNK
    n = L // c

    def hc(t):
        return jnp.swapaxes(t.astype(F32), 1, 2).reshape((B, H, n, c) + t.shape[3:])

    q, k, v, g, beta = hc(q), hc(k), hc(v), hc(g), hc(beta)
    g = jnp.cumsum(g, axis=-1)
    idx = jnp.arange(c)
    incl = idx[:, None] >= idx[None, :]
    strict = idx[:, None] > idx[None, :]
    decay = jnp.where(incl, jnp.exp(jnp.where(incl, g[..., :, None] - g[..., None, :], 0.0)), 0.0)
    kb = k * beta[..., None]
    lower = jnp.where(strict, jnp.einsum('bhnid,bhnjd->bhnij', kb, k) * decay, 0.0)
    eye = jnp.eye(c, dtype=F32)
    tmat = lax.linalg.triangular_solve(eye + lower, jnp.broadcast_to(eye, lower.shape),
                                       left_side=True, lower=True, unit_diagonal=True)
    u = tmat @ (v * beta[..., None])
    w = tmat @ (kb * jnp.exp(g)[..., None])
    qk = jnp.einsum('bhnid,bhnjd->bhnij', q, k) * decay
    eg = jnp.exp(g)
    k_tail = k * jnp.exp(g[..., -1:] - g)[..., None]
    g_last = jnp.exp(g[..., -1])

    def step(s, inp):
        qi, ui, wi, qki, egi, kti, gli = inp
        v_new = ui - wi @ s
        o = (qi * egi[..., None]) @ s + qki @ v_new
        s = s * gli[..., None, None] + jnp.swapaxes(kti, -1, -2) @ v_new
        return s, o

    xs = tuple(jnp.moveaxis(t, 2, 0) for t in (q, u, w, qk, eg, k_tail, g_last))
    s, o = lax.scan(step, s0.astype(F32), xs)
    o = jnp.moveaxis(o, 0, 2).reshape(B, H, L, dv)
    return jnp.swapaxes(o, 1, 2), s


def deltanet_branch(q, k, v, gate, a, b, n_ctx, conv_w, a_log, dt_bias, norm_gain):
    B, L, _ = q.shape
    H = DN_HEADS
    qkv = jnp.concatenate([q, k, v], axis=-1)
    qkv = jax.nn.silu(jnp.concatenate([short_conv(qkv[:, :n_ctx], conv_w),
                                       short_conv(qkv[:, n_ctx:], conv_w)], axis=1))
    q, k, v = jnp.split(qkv, [H * DN_DK, 2 * H * DN_DK], axis=-1)
    q = l2_normalize(q.reshape(B, L, H, DN_DK)) * (DN_DK ** -0.5)
    k = l2_normalize(k.reshape(B, L, H, DN_DK))
    v = v.reshape(B, L, H, DN_DV)
    g = -jnp.exp(a_log.astype(F32)) * jax.nn.softplus(a.reshape(B, L, 2, H).astype(F32) + dt_bias.astype(F32))
    beta = jax.nn.sigmoid(b.reshape(B, L, 2, H).astype(F32))
    s0 = jnp.zeros((B, H, DN_DK, DN_DV), F32)

    def run(direction):
        seq = (q, k, v, g[:, :, direction], beta[:, :, direction])
        return prefix_scan(gated_delta_chunked, tuple(t[:, :n_ctx] for t in seq),
                           tuple(t[:, n_ctx:] for t in seq), s0, direction == 1)

    y = rms_norm(run(0) + run(1), norm_gain) * jax.nn.silu(gate.astype(F32)).reshape(B, L, H, DN_DV)
    return y.reshape(B, L, H * DN_DV).astype(gate.dtype)


def mixer_sublayer(hz, n_ctx, ang_r, ang_c, ang_t, lam_init, w_in, na_qk_gain, na_rpb, ret_decay, ret_gn,
                   diff_qk_gain, diff_lam, diff_subln, dn_conv, dn_a_log, dn_dt_bias, dn_norm,
                   w_branch, w_mgate, b_mgate, w_out):
    B, L, D = hz.shape
    p = hz @ w_in
    (na_q, na_k, na_v, r_q, r_k, r_v, r_g, df_q, df_k, df_v,
     dn_q, dn_k, dn_v, dn_g, dn_a, dn_b) = jnp.split(p, [int(i) for i in np.cumsum(IN_SPLITS)[:-1]], axis=-1)
    y_na = neighbourhood_branch(na_q, na_k, na_v, n_ctx, na_qk_gain, na_rpb)
    y_ret = retention_branch(r_q, r_k, r_v, r_g, n_ctx, ang_t, ret_decay, ret_gn)
    y_diff = diff_branch(df_q, df_k, df_v, n_ctx, ang_r, ang_c, diff_qk_gain, diff_lam, diff_subln, lam_init)
    y_dn = deltanet_branch(dn_q, dn_k, dn_v, dn_g, dn_a, dn_b, n_ctx, dn_conv, dn_a_log, dn_dt_bias, dn_norm)
    ys = jnp.stack([y_na, y_ret, y_diff, y_dn], axis=2)
    branches = jnp.einsum('blnf,nfd->blnd', ys, w_branch)
    gates = jax.nn.sigmoid((hz @ w_mgate + b_mgate).astype(F32)).astype(hz.dtype).reshape(B, L, N_BRANCH, D)
    return jnp.einsum('blnd,blnd->bld', gates, branches) @ w_out


def moe_ffn(h, router_w, router_b, w_gu, b_gu, w_down, b_down):
    T, D = h.shape
    logits = (h @ router_w + router_b).astype(F32)
    top_val, top_idx = lax.top_k(logits, TOP_K)
    gates = jax.nn.softmax(top_val, axis=-1)
    A = T * TOP_K
    flat_e = top_idx.reshape(A)
    order = jnp.argsort(flat_e)
    sorted_e = flat_e[order]
    counts = jnp.bincount(flat_e, length=N_EXPERTS)
    starts = jnp.cumsum(counts) - counts
    padded = (counts + MOE_BLOCK - 1) // MOE_BLOCK * MOE_BLOCK
    pad_end = jnp.cumsum(padded)
    pad_start = pad_end - padded
    dest = pad_start[sorted_e] + jnp.arange(A) - starts[sorted_e]
    n_blocks = -(-(A + N_EXPERTS * (MOE_BLOCK - 1)) // MOE_BLOCK)
    tok = order // TOP_K
    rows = jnp.zeros((n_blocks * MOE_BLOCK, D), h.dtype).at[dest].set(h[tok])
    block_e = jnp.minimum(jnp.searchsorted(pad_end, jnp.arange(n_blocks) * MOE_BLOCK, side='right'), N_EXPERTS - 1)

    def expert_block(args):
        xb, e = args
        gu = xb @ w_gu[e] + b_gu[e]
        gate, up = jnp.split(gu, 2, axis=-1)
        gate = jnp.minimum(gate, SWIGLU_LIMIT)
        up = jnp.clip(up, -SWIGLU_LIMIT, SWIGLU_LIMIT)
        y = (up + 1.0) * (gate * jax.nn.sigmoid(SWIGLU_ALPHA * gate))
        return y @ w_down[e] + b_down[e]

    out = lax.map(expert_block, (rows.reshape(n_blocks, MOE_BLOCK, D), block_e)).reshape(-1, D)
    y = out[dest] * gates.reshape(A)[order][:, None].astype(h.dtype)
    return jax.ops.segment_sum(y, tok, num_segments=T)


def setup_inputs(seed: int = 0) -> dict:
    key = jax.random.key(seed)
    ks = iter(jax.random.split(key, 40))

    def nrm(shape, scale):
        return jax.random.normal(next(ks), shape, F32) * scale

    def gain(shape):
        return 1.0 + nrm(shape, 0.02)

    Ly, D = DEPTH, D_MODEL
    gamma0 = 1.0 - 2.0 ** (-5.0 - np.arange(RET_HEADS, dtype=np.float32))
    ret_logit0 = jnp.asarray(np.log(gamma0 / (1.0 - gamma0)), F32)
    dt = jnp.exp(jax.random.uniform(next(ks), (Ly, 2, DN_HEADS), F32, math.log(1e-3), math.log(1e-1)))
    a0 = jax.random.uniform(next(ks), (Ly, 2, DN_HEADS), F32, 1.0, 16.0)
    return {
        'x': nrm((BATCH, SEQ, D), 1.0),
        'c': nrm((BATCH, D), 1.0),
        'ctx': nrm((BATCH, CTX_LEN, D), 1.0),
        'c_ctx': nrm((D,), 1.0),
        'w_ada': nrm((Ly, D, 6 * D), 0.5 * D ** -0.5),
        'b_ada': nrm((Ly, 6 * D), 0.02),
        'norm_mix': gain((Ly, D)),
        'norm_ffn': gain((Ly, D)),
        'w_in': nrm((Ly, D, D_IN), D ** -0.5),
        'na_qk_gain': gain((Ly, 2, HEAD_DIM)),
        'na_rpb': nrm((Ly, NA_HEADS, 2 * NA_WIN_R - 1, 2 * NA_WIN_C - 1), 0.1),
        'ret_decay': ret_logit0 + nrm((Ly, 2, RET_HEADS), 0.05),
        'ret_gn': gain((Ly, RET_DV)),
        'diff_qk_gain': gain((Ly, 2, DIFF_DK)),
        'diff_lam': nrm((Ly, 4, DIFF_DK), 0.1),
        'diff_subln': gain((Ly, DIFF_DV)),
        'dn_conv': nrm((Ly, DN_CONV, DN_CONV_CH), DN_CONV ** -0.5),
        'dn_a_log': jnp.log(a0),
        'dn_dt_bias': jnp.log(jnp.expm1(dt)),
        'dn_norm': gain((Ly, DN_DV)),
        'w_branch': nrm((Ly, N_BRANCH, BRANCH_W, D), BRANCH_W ** -0.5),
        'w_mgate': nrm((Ly, D, N_BRANCH * D), D ** -0.5),
        'b_mgate': nrm((Ly, N_BRANCH * D), 0.02),
        'w_out': nrm((Ly, D, D), D ** -0.5),
        'router_w': nrm((Ly, D, N_EXPERTS), D ** -0.5),
        'router_b': nrm((Ly, N_EXPERTS), 0.01),
        'w_gu': nrm((Ly, N_EXPERTS, D, 2 * D_FF), D ** -0.5),
        'b_gu': nrm((Ly, N_EXPERTS, 2 * D_FF), 0.01),
        'w_down': nrm((Ly, N_EXPERTS, D_FF, D), D_FF ** -0.5),
        'b_down': nrm((Ly, N_EXPERTS, D), 0.01),
    }


def reference(x, c, ctx, c_ctx, w_ada, b_ada, norm_mix, norm_ffn, w_in, na_qk_gain, na_rpb,
              ret_decay, ret_gn, diff_qk_gain, diff_lam, diff_subln, dn_conv, dn_a_log, dn_dt_bias,
              dn_norm, w_branch, w_mgate, b_mgate, w_out, router_w, router_b, w_gu, b_gu, w_down, b_down):
    B, S, D = x.shape
    n_ctx = ctx.shape[1]
    t = jnp.arange(S)
    ang_r = rope_angles(t // GRID_W, HEAD_DIM // 2)
    ang_c = rope_angles(t % GRID_W, HEAD_DIM // 2)
    ang_t = rope_angles(t, RET_DK)
    xc, xl = ctx, x
    for l in range(DEPTH):
        lam_init = 0.8 - 0.6 * math.exp(-0.3 * l)
        ml = jnp.split((jax.nn.silu(c) @ w_ada[l] + b_ada[l])[:, None, :], 6, axis=-1)
        mc = jnp.split(jax.nn.silu(c_ctx) @ w_ada[l] + b_ada[l], 6, axis=-1)
        ffn = functools.partial(moe_ffn, router_w=router_w[l], router_b=router_b[l], w_gu=w_gu[l],
                                b_gu=b_gu[l], w_down=w_down[l], b_down=b_down[l])
        hz = jnp.concatenate([modulate(rms_norm(xc, norm_mix[l]), mc[0], mc[1]),
                              modulate(rms_norm(xl, norm_mix[l]), ml[0], ml[1])], axis=1)
        mix = mixer_sublayer(hz, n_ctx, ang_r, ang_c, ang_t, lam_init, w_in[l], na_qk_gain[l], na_rpb[l],
                             ret_decay[l], ret_gn[l], diff_qk_gain[l], diff_lam[l], diff_subln[l],
                             dn_conv[l], dn_a_log[l], dn_dt_bias[l], dn_norm[l],
                             w_branch[l], w_mgate[l], b_mgate[l], w_out[l])
        xl = xl + ml[2] * mix[:, n_ctx:]
        hl = modulate(rms_norm(xl, norm_ffn[l]), ml[3], ml[4])
        if l == DEPTH - 1:
            xl = xl + ml[5] * ffn(hl.reshape(-1, D)).reshape(B, S, D)
        else:
            xc = xc + mc[2] * mix[:, :n_ctx]
            hc = modulate(rms_norm(xc, norm_ffn[l]), mc[3], mc[4])
            f = ffn(jnp.concatenate([hc, hl], axis=1).reshape(-1, D)).reshape(B, n_ctx + S, D)
            xc = xc + mc[5] * f[:, :n_ctx]
            xl = xl + ml[5] * f[:, n_ctx:]
    return xl
```

```cpp
#include <hip/hip_runtime.h>
#include <hip/hip_cooperative_groups.h>
#include <cstdio>
#include <cstdint>
namespace cg = cooperative_groups;

#define LAS __attribute__((address_space(3)))
#define DI __device__ __forceinline__
typedef unsigned short bf16_t;
typedef short bf16x8 __attribute__((ext_vector_type(8)));
typedef float f32x4 __attribute__((ext_vector_type(4)));
typedef float f32x2 __attribute__((ext_vector_type(2)));
typedef unsigned u32x4 __attribute__((ext_vector_type(4)));
typedef unsigned u32x2 __attribute__((ext_vector_type(2)));
typedef int i32x4 __attribute__((ext_vector_type(4)));
typedef int i32x8 __attribute__((ext_vector_type(8)));
constexpr int FP8_WSHIFT = 7, FP8_WSCALE = 127 - FP8_WSHIFT;

constexpr int D = 1024, NBATCH = 8, SEQ = 2048, CTX = 256, LTOK = SEQ + CTX, T = NBATCH * LTOK, DEPTH = 2;
constexpr int GRID_W = 64, GRID_R = 32;
constexpr int PW = 6400;
constexpr int NG1 = 6400 + 4096;
constexpr int NE = 32, TOPK = 4, A_TOT = T * TOPK, AMAX = T;
constexpr int YSW = 2048;
constexpr int C_NAQ = 0, C_NAK = 512, C_NAV = 1024, C_RQ = 1536, C_RK = 1792, C_RV = 2048, C_RG = 2560, C_DFQ = 3072, C_DFK = 3584, C_DFV = 4096,
              C_DNQ = 4608, C_DNK = 4864, C_DNV = 5120, C_DNG = 5632;
constexpr float EPS = 1e-6f;

enum { I_X = 0, I_C, I_CTX, I_CCTX, I_WADA, I_BADA, I_NMIX, I_NFFN, I_WIN, I_NAQKG, I_NARPB, I_RETDEC, I_RETGN, I_DFQKG, I_DFLAM, I_DFSUB, I_DNCONV, I_DNALOG,
       I_DNDT, I_DNNORM, I_WBR, I_WMG, I_BMG, I_WOUT, I_RW, I_RB, I_WGU, I_BGU, I_WDN, I_BDN, N_IN };

constexpr size_t al256(size_t x) { return (x + 255) & ~(size_t)255; }
constexpr size_t WS_W1T = 0;
constexpr size_t WS_WBT = WS_W1T + al256((size_t)2 * NG1 * D * 2);
constexpr size_t WS_WOT = WS_WBT + al256((size_t)2 * 4 * D * 512 * 2);
constexpr size_t WS_WGU = WS_WOT + al256((size_t)2 * D * D * 2);
constexpr size_t WS_WDN = WS_WGU + al256((size_t)2 * NE * 2048 * D * 2);
constexpr size_t WS_MOD = WS_WDN + al256((size_t)2 * NE * D * D * 2);
constexpr size_t WS_ROPE = WS_MOD + al256((size_t)2 * 9 * 6144 * 4);
constexpr size_t ROPE_FLOATS = 2 * 2048 * 32 + 2 * 32 * 16 + 2 * 64 * 16;
constexpr size_t WS_CNT = WS_ROPE + al256(ROPE_FLOATS * 4);
constexpr size_t WS_AMAP = WS_CNT + 256;
constexpr size_t WS_GATEB = WS_AMAP + al256((size_t)2 * NE * AMAX * 4);
constexpr size_t WS_HZ = WS_GATEB + al256((size_t)2 * A_TOT * 4);
constexpr size_t WS_XRES = WS_HZ + al256((size_t)(T + 256) * D * 2);
constexpr size_t WS_AB = WS_XRES + al256((size_t)T * D * 4);
constexpr size_t WS_OSEQ = WS_AB + al256((size_t)T * 16 * 4);
constexpr size_t WS_YS = WS_OSEQ + al256((size_t)4 * T * 512 * 4);
constexpr size_t WS_MIXED = WS_YS + al256((size_t)T * YSW * 2);
constexpr size_t WS_P = WS_MIXED + al256((size_t)T * D * 2);
constexpr size_t WS_GATES = WS_P + al256((size_t)T * PW * 2);
constexpr int NCHUNK = LTOK / 64, NSEQ = 2 * NBATCH * 4 * 2, NCI = NSEQ * NCHUNK;
constexpr size_t WS_SEQT = WS_GATES + al256((size_t)T * 4096 * 2);
constexpr size_t WS_SEQU = WS_SEQT + (size_t)NCI * 32768;
constexpr size_t WS_SEQG = WS_SEQU + (size_t)NCI * 16384;
constexpr size_t WS_HZ8 = WS_SEQG + al256((size_t)NCI * 4);
constexpr size_t WS_WMG8 = WS_HZ8 + al256((size_t)T * D);
constexpr size_t WS_WAB = WS_WMG8 + al256((size_t)2 * 4096 * D);
constexpr size_t WS_RWT = WS_WAB + al256((size_t)2 * 16 * D * 4);
constexpr size_t WS_BAR = WS_RWT + al256((size_t)2 * NE * D * 4);
constexpr size_t WS_END = WS_BAR + 16384;
constexpr size_t WS_YBUF = WS_P;
constexpr size_t WS_OBUF = WS_YBUF + al256((size_t)(A_TOT + 1) * D * 2);
static_assert(WS_OBUF + (size_t)(A_TOT + 1) * D * 2 <= WS_END, "moe overlay");

constexpr int LDS_RING = 131072;
constexpr int LDS_MISC = LDS_RING;
constexpr int LDS_BYTES = 147456;

DI float bf2f(bf16_t b) { return __uint_as_float(((unsigned)b) << 16); }
DI unsigned f2bf(float f) { unsigned u = __float_as_uint(f); return (u + 0x7fffu + ((u >> 16) & 1u)) >> 16; }
DI unsigned pk2(float lo, float hi);
typedef __bf16 bf2_t __attribute__((ext_vector_type(2)));
DI unsigned cvt_pk_bf16(float lo, float hi) { const bf2_t r = __builtin_convertvector((f32x2){lo, hi}, bf2_t); return __builtin_bit_cast(unsigned, r); }
DI unsigned hw_lane() { return __builtin_amdgcn_mbcnt_hi(~0u, __builtin_amdgcn_mbcnt_lo(~0u, 0u)); }
template <int MASK> DI unsigned xshfl_u(unsigned u) {
    if constexpr (MASK == 1) return __builtin_amdgcn_update_dpp(u, u, 0xB1, 0xF, 0xF, false);
    else if constexpr (MASK == 2) return __builtin_amdgcn_update_dpp(u, u, 0x4E, 0xF, 0xF, false);
    else if constexpr (MASK == 4) { const unsigned a = __builtin_amdgcn_update_dpp(u, u, 0x141, 0xF, 0xF, false); return __builtin_amdgcn_update_dpp(a, a, 0x1B, 0xF, 0xF, false); }
    else if constexpr (MASK == 8) { const unsigned a = __builtin_amdgcn_update_dpp(u, u, 0x140, 0xF, 0xF, false); return __builtin_amdgcn_update_dpp(a, a, 0x141, 0xF, 0xF, false); }
    else if constexpr (MASK == 16) { const auto r = __builtin_amdgcn_permlane16_swap(u, u, false, false); return (hw_lane() & 16) ? r[0] : r[1]; }
    else { static_assert(MASK == 32, "xshfl mask"); const auto r = __builtin_amdgcn_permlane32_swap(u, u, false, false); return (hw_lane() & 32) ? r[0] : r[1]; }
}
template <int MASK> DI float xshfl(float v) { return __uint_as_float(xshfl_u<MASK>(__float_as_uint(v))); }
template <int MASK> DI int xshfl(int v) { return (int)xshfl_u<MASK>((unsigned)v); }
DI unsigned pk2(float lo, float hi) { return cvt_pk_bf16(lo, hi); }
DI float wave_sum(float v) { v += xshfl<1>(v); v += xshfl<2>(v); v += xshfl<4>(v); v += xshfl<8>(v); v += xshfl<16>(v); v += xshfl<32>(v); return v; }
DI float sigmoidf_(float x) { return __builtin_amdgcn_rcpf(1.f + __expf(-x)); }
DI float siluf_(float x) { return x * __builtin_amdgcn_rcpf(1.f + __expf(-x)); }
DI void unpack8(const u32x4 w, float (&f)[8]) {
    f[0] = __uint_as_float(w.x << 16); f[1] = __uint_as_float(w.x & 0xffff0000u); f[2] = __uint_as_float(w.y << 16); f[3] = __uint_as_float(w.y & 0xffff0000u);
    f[4] = __uint_as_float(w.z << 16); f[5] = __uint_as_float(w.z & 0xffff0000u); f[6] = __uint_as_float(w.w << 16); f[7] = __uint_as_float(w.w & 0xffff0000u);
}
DI unsigned pk4_fp8(float a, float b, float c, float d) { unsigned r = 0; r = __builtin_amdgcn_cvt_pk_fp8_f32(fminf(fmaxf(a, -448.f), 448.f), fminf(fmaxf(b, -448.f), 448.f), r, false); r = __builtin_amdgcn_cvt_pk_fp8_f32(fminf(fmaxf(c, -448.f), 448.f), fminf(fmaxf(d, -448.f), 448.f), r, true); return r; }
DI u32x2 pack8_fp8(const float (&f)[8]) { u32x2 w; w.x = pk4_fp8(f[0], f[1], f[2], f[3]); w.y = pk4_fp8(f[4], f[5], f[6], f[7]); return w; }
DI f32x4 unpack4(const u32x2 w) { return (f32x4){__uint_as_float(w.x << 16), __uint_as_float(w.x & 0xffff0000u), __uint_as_float(w.y << 16), __uint_as_float(w.y & 0xffff0000u)}; }
DI u32x2 pack4(const f32x4 v) { u32x2 w; w.x = pk2(v[0], v[1]); w.y = pk2(v[2], v[3]); return w; }
DI u32x4 pack8(const float (&f)[8]) { u32x4 w; w.x = pk2(f[0], f[1]); w.y = pk2(f[2], f[3]); w.z = pk2(f[4], f[5]); w.w = pk2(f[6], f[7]); return w; }

constexpr float G8S = 8.f;
constexpr float O8S = 16.f;
typedef const float* cfp_t;
#define GIN(inp, i) ((const float*)(const __attribute__((address_space(1))) float*)(inp)[i])
struct Params { const float* in[N_IN]; float* out; unsigned char* ws; int ph_lo, ph_hi, G, pad; };

namespace pg8 {
constexpr int BM = 256, BK = 64, HALF = 128, HTB = HALF * BK * 2, NXCD = 8, WGM = 8;
DI int lds_byte(int r, int c) { const int st = (r >> 4) * 2 + (c >> 5), rr = r & 15, cc = c & 31, ob = rr * 64 + cc * 2; return st * 1024 + (ob ^ (((ob >> 9) & 1) << 5)); }
DI void stage_rc(int b, int& R, int& C) { const int st = b / 1024, sb = b % 1024, swz = sb ^ (((sb >> 9) & 1) << 5); R = (st >> 1) * 16 + swz / 64; C = (st & 1) * 32 + (swz % 64) / 2; }
DI int perm32(int rho) { const int n = rho >> 4, i = rho & 15; return 8 * (i >> 2) + 4 * n + (i & 3); }
struct Unit { int pm, pn, aux; };

template <bool FP8, class Epi, class Sched>
DI void gemm_phase(const int tid, LAS unsigned char* lds, const char* Abase, const int K, const Sched& S, const Epi& E) {
    const int wid = __builtin_amdgcn_readfirstlane(tid >> 6), lane = tid & 63, wr = wid >> 2, wc = wid & 3, fr = lane & 15, fq = lane >> 4;
    const int nt = K / BK;
    unsigned voffB[2];
#pragma unroll
    for (int i = 0; i < 2; ++i) { int R, C; stage_rc(tid * 16 + i * 8192, R, C); const int Rb = (R & ~31) + perm32(R & 31); voffB[i] = (unsigned)(Rb * K + C) * 2u; }
    const size_t kstep = (size_t)(BK * 2);
    const size_t hstepB = (size_t)HALF * K * 2;
    const unsigned ldsw = (unsigned)wid * 1024u;
    const int aoff = lds_byte(wr * 64 + fr, fq * 8), boff = lds_byte(wc * 32 + fr, fq * 8);
#define PG8_SA(b, h) (((b) * 2 + (h)) * HTB)
#define PG8_SB(b, h) ((4 + (b) * 2 + (h)) * HTB)
#define PG8_STAGE2(bufoff, gbase, o0, o1) do { \
        __builtin_amdgcn_global_load_lds((const unsigned*)((const char*)(gbase) + (o0)), (LAS unsigned*)(lds + (bufoff) + ldsw), 16, 0, 0); \
        __builtin_amdgcn_global_load_lds((const unsigned*)((const char*)(gbase) + (o1)), (LAS unsigned*)(lds + (bufoff) + ldsw + 8192), 16, 0, 0); } while (0)
#define PG8_STAGEB(bufoff, gbase) PG8_STAGE2(bufoff, gbase, voffB[0], voffB[1])
#define PG8_LD8(p) __builtin_shufflevector(*(const LAS i32x4*)(p), *(const LAS i32x4*)((p) + 1024), 0, 1, 2, 3, 4, 5, 6, 7)
#define PG8_LDA(dst, b, h) do { _Pragma("unroll") for (int m = 0; m < 4; ++m) { if constexpr (FP8) dst[m].w = PG8_LD8(lds + PG8_SA(b, h) + aoff + m * 2048); else { _Pragma("unroll") for (int k = 0; k < 2; ++k) dst[m].v2[k] = *(const LAS bf16x8*)(lds + PG8_SA(b, h) + aoff + m * 2048 + k * 1024); } } } while (0)
#define PG8_LDB(dst, b, h) do { _Pragma("unroll") for (int n = 0; n < 2; ++n) { if constexpr (FP8) dst[n].w = PG8_LD8(lds + PG8_SB(b, h) + boff + n * 2048); else { _Pragma("unroll") for (int k = 0; k < 2; ++k) dst[n].v2[k] = *(const LAS bf16x8*)(lds + PG8_SB(b, h) + boff + n * 2048 + k * 1024); } } } while (0)
#define PG8_MMA(ai, bj, At, Bt) do { __builtin_amdgcn_s_setprio(1); _Pragma("unroll") for (int m = 0; m < 4; ++m) _Pragma("unroll") for (int n = 0; n < 2; ++n) { \
        if constexpr (FP8) acc[ai][bj][m][n] = __builtin_amdgcn_mfma_scale_f32_16x16x128_f8f6f4(Bt[n].w, At[m].w, acc[ai][bj][m][n], 0, 0, 0, FP8_WSCALE, 0, 127); \
        else { _Pragma("unroll") for (int k = 0; k < 2; ++k) acc[ai][bj][m][n] = __builtin_amdgcn_mfma_f32_16x16x32_bf16(Bt[n].v2[k], At[m].v2[k], acc[ai][bj][m][n], 0, 0, 0); } } __builtin_amdgcn_s_setprio(0); } while (0)
#define PG8_WAIT_V(n) asm volatile("s_waitcnt vmcnt(" #n ")" ::: "memory")
#define PG8_WAIT_L(n) asm volatile("s_waitcnt lgkmcnt(" #n ")" ::: "memory")
#define PG8_BAR __builtin_amdgcn_s_barrier()
#define PG8_SCHED __builtin_amdgcn_sched_barrier(0)
    Unit cur, nxt; int ui = 0;
    if (!S.next(0, cur)) return;
    f32x4 acc[2][2][4][2];
#pragma unroll
    for (int a = 0; a < 2; ++a)
#pragma unroll
        for (int b = 0; b < 2; ++b)
#pragma unroll
            for (int m = 0; m < 4; ++m)
#pragma unroll
                for (int n = 0; n < 2; ++n) acc[a][b][m][n] = (f32x4){0.f, 0.f, 0.f, 0.f};
    union Frag { bf16x8 v2[2]; i32x8 w; };
    Frag At[4], B0[2], B1[2];
    unsigned oc[2][2];
    S.a_off(tid, cur, oc);
    const char* cB = S.b_ptr(cur);
    const char* cA = Abase;
    PG8_STAGEB(PG8_SB(0, 0), cB); PG8_STAGEB(PG8_SB(0, 1), cB + hstepB); PG8_STAGE2(PG8_SA(0, 0), cA, oc[0][0], oc[0][1]); PG8_STAGE2(PG8_SA(0, 1), cA, oc[1][0], oc[1][1]);
    if (wr == 1) PG8_BAR;
    PG8_WAIT_V(2); PG8_BAR;
    PG8_STAGEB(PG8_SB(1, 0), cB + kstep); PG8_STAGE2(PG8_SA(1, 0), cA + kstep, oc[0][0], oc[0][1]); PG8_STAGEB(PG8_SB(1, 1), cB + hstepB + kstep);
    PG8_WAIT_V(6); PG8_BAR;
    for (;;) {
        const bool has_next = S.next(ui + 1, nxt);
        const char* nB = cB;
        if (has_next) nB = S.b_ptr(nxt);
#pragma unroll 1
        for (int t = 0; t < nt; t += 2) {
            const bool last = (t == nt - 2);
            const char* a1 = cA + (size_t)(t + 1) * kstep;
            const char* a2 = last ? cA : cA + (size_t)(t + 2) * kstep; const char* b2 = last ? nB : cB + (size_t)(t + 2) * kstep;
            const char* a3 = a2 + kstep; const char* b3 = b2 + kstep;
            PG8_LDB(B0, 0, 0); PG8_LDB(B1, 0, 1); PG8_SCHED; PG8_LDA(At, 0, 0); PG8_STAGE2(PG8_SA(1, 1), a1, oc[1][0], oc[1][1]);
            if (last && has_next && S.a_changes(cur, nxt)) S.a_off(tid, nxt, oc);
            PG8_WAIT_V(8); PG8_WAIT_L(0); PG8_BAR; PG8_MMA(0, 0, At, B0); PG8_MMA(0, 1, At, B1); PG8_BAR; PG8_SCHED;
            PG8_LDA(At, 0, 1); PG8_STAGEB(PG8_SB(0, 0), b2); PG8_STAGEB(PG8_SB(0, 1), b2 + hstepB); PG8_STAGE2(PG8_SA(0, 0), a2, oc[0][0], oc[0][1]);
            PG8_WAIT_V(8); PG8_WAIT_L(0); PG8_BAR; PG8_MMA(1, 0, At, B0); PG8_MMA(1, 1, At, B1); PG8_BAR; PG8_SCHED;
            PG8_LDB(B0, 1, 0); PG8_LDB(B1, 1, 1); PG8_SCHED; PG8_LDA(At, 1, 0); PG8_STAGE2(PG8_SA(0, 1), a2, oc[1][0], oc[1][1]);
            PG8_WAIT_V(8); PG8_WAIT_L(0); PG8_BAR; PG8_MMA(0, 0, At, B0); PG8_MMA(0, 1, At, B1); PG8_BAR; PG8_SCHED;
            PG8_LDA(At, 1, 1); PG8_STAGEB(PG8_SB(1, 0), b3); PG8_STAGEB(PG8_SB(1, 1), b3 + hstepB); PG8_STAGE2(PG8_SA(1, 0), a3, oc[0][0], oc[0][1]);
            PG8_WAIT_V(8); PG8_WAIT_L(0); PG8_BAR; PG8_MMA(1, 0, At, B0); PG8_MMA(1, 1, At, B1); PG8_BAR; PG8_SCHED;
        }
        if (wr == 0) PG8_BAR;
        { int fr2 = fr, fq2 = fq; asm volatile("" : "+v"(fr2), "+v"(fq2));
          E(acc, cur, wr, wc, fr2, fq2); }
        if (!has_next) break;
#pragma unroll
        for (int a = 0; a < 2; ++a)
#pragma unroll
            for (int b = 0; b < 2; ++b)
#pragma unroll
                for (int m = 0; m < 4; ++m)
#pragma unroll
                    for (int n = 0; n < 2; ++n) acc[a][b][m][n] = (f32x4){0.f, 0.f, 0.f, 0.f};
        cur = nxt; cB = nB; ++ui;
        if (wr == 1) PG8_BAR;
    }
    PG8_WAIT_V(0);
    PG8_BAR;
#undef PG8_SA
#undef PG8_SB
#undef PG8_STAGE2
#undef PG8_STAGEB
#undef PG8_LDA
#undef PG8_LDB
#undef PG8_MMA
#undef PG8_WAIT_V
#undef PG8_WAIT_L
#undef PG8_BAR
#undef PG8_SCHED
}

struct DenseSched {
    int nM, nN, nwg, G, c, lda, K, i0 = 0, i1 = 1 << 30; bool lat; const char* Bt;
    DI void init(int M, int N, int K_, int lda_, const void* Bt_, int G_, int c_, bool lat_ = false) { lat = lat_; nM = lat_ ? NBATCH * 8 : M / BM; nN = N / BM; nwg = nM * nN; G = G_; c = c_; lda = lda_; K = K_; Bt = (const char*)Bt_; }
    DI bool next(int i, Unit& u) const {
        if (i + i0 >= i1) return false;
        const long L = (long)(i + i0) * G + c; if (L >= nwg) return false;
        int wgid = (int)L; { const int q = nwg / NXCD, r = nwg % NXCD, xcd = wgid % NXCD, off = wgid / NXCD; wgid = (xcd < r ? xcd * (q + 1) : r * (q + 1) + (xcd - r) * q) + off; }
        const int nig = WGM * nN, gid = wgid / nig, fm = gid * WGM, gsz = (nM - fm) < WGM ? (nM - fm) : WGM;
        u.pm = fm + ((wgid % nig) % gsz); u.pn = (wgid % nig) / gsz; u.aux = 0; if (lat) u.pm = (u.pm >> 3) * 9 + 1 + (u.pm & 7); return true;
    }
    DI bool a_changes(const Unit& a, const Unit& b) const { return a.pm != b.pm; }
    DI const char* b_ptr(const Unit& u) const { return Bt + (size_t)u.pn * BM * K * 2; }
    DI void a_off(const int tid, const Unit& u, unsigned (&off)[2][2]) const {
#pragma unroll
        for (int i = 0; i < 2; ++i) { int R, C; stage_rc(tid * 16 + i * 8192, R, C);
#pragma unroll
            for (int h = 0; h < 2; ++h) off[h][i] = (unsigned)((u.pm * BM + h * HALF + R) * lda + C) * 2u; }
    }
};
struct BranchSched {
    int nM, nwg, G, c; bool lat; const char* Bt;
    DI void init(bool lat_, const void* Bt_, int G_, int c_) { lat = lat_; nM = lat_ ? NBATCH * 8 : T / BM; nwg = nM * 16; G = G_; c = c_; Bt = (const char*)Bt_; }
    DI bool next(int i, Unit& u) const {
        const int L = i * G + c; if (L >= nwg) return false;
        const int pmv = L >> 4; u.pm = lat ? (pmv >> 3) * 9 + 1 + (pmv & 7) : pmv; u.pn = L & 3; u.aux = (L >> 2) & 3; return true;
    }
    DI bool a_changes(const Unit& a, const Unit& b) const { return a.pm != b.pm || a.aux != b.aux; }
    DI const char* b_ptr(const Unit& u) const { return Bt + ((size_t)u.aux * D + (size_t)u.pn * BM) * 512 * 2; }
    DI void a_off(const int tid, const Unit& u, unsigned (&off)[2][2]) const {
#pragma unroll
        for (int i = 0; i < 2; ++i) { int R, C; stage_rc(tid * 16 + i * 8192, R, C);
#pragma unroll
            for (int h = 0; h < 2; ++h) off[h][i] = (unsigned)((u.pm * BM + h * HALF + R) * YSW + u.aux * 512 + C) * 2u; }
    }
};
template <int NT, int NROWS, bool TOKROWS>
struct MoeSched {
    const LAS int* pref; int G, c; const char* Bt; const int* amap;
    DI bool next(int i, Unit& u) const {
        const int L = i * G + c; const int total = pref[NE] * NT; if (L >= total) return false;
        const int mtg = L / NT; int e = 0;
        while (pref[e + 1] <= mtg) ++e;
        u.aux = e; u.pm = mtg - pref[e]; u.pn = L % NT; return true;
    }
    DI bool a_changes(const Unit& a, const Unit& b) const { return a.pm != b.pm || a.aux != b.aux; }
    DI const char* b_ptr(const Unit& u) const { return Bt + ((size_t)u.aux * NROWS + (size_t)u.pn * BM) * D; }
    DI void a_off(const int tid, const Unit& u, unsigned (&off)[2][2]) const {
#pragma unroll
        for (int i = 0; i < 2; ++i) { int R, C; stage_rc(tid * 16 + i * 8192, R, C);
#pragma unroll
            for (int h = 0; h < 2; ++h) { int rid = amap[(size_t)u.aux * AMAX + u.pm * BM + h * HALF + R]; if (TOKROWS) rid >>= 2; off[h][i] = (unsigned)(rid * (D / 2) + C) * 2u; } }
    }
};

struct EpiP {
    unsigned char* ws; const __attribute__((address_space(4))) cfp_t* in; LAS unsigned char* ldsb; int layer;
    DI void operator()(const f32x4 (&acc)[2][2][4][2], const Unit& u, int wr, int wc, int fr, int fq) const {
        bf16_t* p = (bf16_t*)(ws + WS_P); const float* rope = (const float*)(ws + WS_ROPE); LAS float* ex = (LAS float*)(ldsb + LDS_MISC);
        const float* gna = GIN(in, I_NAQKG) + (size_t)layer * 128; const float* gdf = GIN(in, I_DFQKG) + (size_t)layer * 128;
        const int row0 = u.pm * BM + wr * 64 + fr, cl = wc * 32 + 8 * fq;
        const int kind = u.pn < 4 ? (u.pn >> 1) : ((u.pn >= 12 && u.pn < 16) ? 2 + ((u.pn - 12) >> 1) : -1);
        if (kind < 0) {
#pragma unroll
            for (int ai = 0; ai < 2; ++ai)
#pragma unroll
                for (int m = 0; m < 4; ++m) { bf16_t* rowp = p + (size_t)(row0 + ai * HALF + m * 16) * PW + u.pn * BM + cl;
#pragma unroll
                    for (int bj = 0; bj < 2; ++bj) { const f32x4 v0 = acc[ai][bj][m][0], v1 = acc[ai][bj][m][1]; u32x4 w; w.x = cvt_pk_bf16(v0[0], v0[1]); w.y = cvt_pk_bf16(v0[2], v0[3]); w.z = cvt_pk_bf16(v1[0], v1[1]); w.w = cvt_pk_bf16(v1[2], v1[3]);
                        *(u32x4*)(rowp + bj * HALF) = w; } }
            return;
        }
        const float* gp = (kind < 2 ? gna : gdf) + (kind & 1) * 64 + (wc & 1) * 32 + 8 * fq;
        const f32x4 g0 = *(const f32x4*)gp, g1 = *(const f32x4*)(gp + 4);
        const float post = (kind & 1) ? 1.f : 0.125f * 1.4426950408889634f;
        const float *cos_r = rope + 2 * 2048 * 32, *sin_r = cos_r + 512, *cos_c = cos_r + 1024, *sin_c = cos_c + 1024;
#pragma unroll
        for (int bj = 0; bj < 2; ++bj) {
            float ss[2][4];
#pragma unroll
            for (int ai = 0; ai < 2; ++ai)
#pragma unroll
                for (int m = 0; m < 4; ++m) { const f32x4 v0 = acc[ai][bj][m][0], v1 = acc[ai][bj][m][1];
                    float q = v0[0] * v0[0] + v0[1] * v0[1] + v0[2] * v0[2] + v0[3] * v0[3] + v1[0] * v1[0] + v1[1] * v1[1] + v1[2] * v1[2] + v1[3] * v1[3];
                    q += xshfl<16>(q); q += xshfl<32>(q); ss[ai][m] = q;
                    if (fq == 0) ex[((wr * 4 + wc) * 8 + ai * 4 + m) * 16 + fr] = q; }
            __syncthreads();
#pragma unroll
            for (int ai = 0; ai < 2; ++ai)
#pragma unroll
                for (int m = 0; m < 4; ++m) ss[ai][m] += ex[((wr * 4 + (wc ^ 1)) * 8 + ai * 4 + m) * 16 + fr];
            __syncthreads();
#pragma unroll
            for (int ai = 0; ai < 2; ++ai)
#pragma unroll
                for (int m = 0; m < 4; ++m) { const int row = row0 + ai * HALF + m * 16; const float rn = rsqrtf(ss[ai][m] * (1.f / 64.f) + EPS) * post;
                    f32x4 v0 = acc[ai][bj][m][0] * rn * g0, v1 = acc[ai][bj][m][1] * rn * g1;
                    if (kind >= 2) { const int b = row / LTOK, pos = row - b * LTOK;
                        f32x4 p0, p1;
#pragma unroll
                        for (int j = 0; j < 4; ++j) { p0[j] = xshfl<32>(v0[j]); p1[j] = xshfl<32>(v1[j]); }
                        if (pos >= CTX) { const int li = pos - CTX; const float* ct = (wc & 1) ? cos_c + (li & 63) * 16 : cos_r + (li >> 6) * 16; const float* st = (wc & 1) ? sin_c + (li & 63) * 16 : sin_r + (li >> 6) * 16;
                            const int f0 = 8 * (fq & 1); const f32x4 c0 = *(const f32x4*)(ct + f0), c1 = *(const f32x4*)(ct + f0 + 4), s0 = *(const f32x4*)(st + f0), s1 = *(const f32x4*)(st + f0 + 4);
                            if (fq < 2) { v0 = v0 * c0 - p0 * s0; v1 = v1 * c1 - p1 * s1; } else { v0 = v0 * c0 + p0 * s0; v1 = v1 * c1 + p1 * s1; } } }
                    u32x4 w; w.x = cvt_pk_bf16(v0[0], v0[1]); w.y = cvt_pk_bf16(v0[2], v0[3]); w.z = cvt_pk_bf16(v1[0], v1[1]); w.w = cvt_pk_bf16(v1[2], v1[3]);
                    *(u32x4*)(p + (size_t)row * PW + u.pn * BM + cl + bj * HALF) = w;
                    asm volatile("" ::: "memory"); }
        }
    }
};
struct EpiGates {
    bf16_t* gates; const float* bmg;
    DI void operator()(const f32x4 (&acc)[2][2][4][2], const Unit& u, int wr, int wc, int fr, int fq) const {
        const int row0 = u.pm * BM + wr * 64 + fr, gc0 = u.pn * BM + wc * 32 + 8 * fq;
        f32x4 bv[2][2];
#pragma unroll
        for (int bj = 0; bj < 2; ++bj)
#pragma unroll
            for (int n = 0; n < 2; ++n) bv[bj][n] = *(const f32x4*)(bmg + gc0 + bj * HALF + 4 * n);
#pragma unroll
        for (int ai = 0; ai < 2; ++ai)
#pragma unroll
            for (int m = 0; m < 4; ++m) { bf16_t* rowp = gates + (size_t)(row0 + ai * HALF + m * 16) * 4096 + gc0;
#pragma unroll
                for (int bj = 0; bj < 2; ++bj) { f32x4 v0 = acc[ai][bj][m][0] + bv[bj][0], v1 = acc[ai][bj][m][1] + bv[bj][1];
#pragma unroll
                    for (int j = 0; j < 4; ++j) { v0[j] = sigmoidf_(v0[j]); v1[j] = sigmoidf_(v1[j]); }
                    u32x4 w; w.x = cvt_pk_bf16(v0[0], v0[1]); w.y = cvt_pk_bf16(v0[2], v0[3]); w.z = cvt_pk_bf16(v1[0], v1[1]); w.w = cvt_pk_bf16(v1[2], v1[3]);
                    *(u32x4*)(rowp + bj * HALF) = w; } }
    }
};
struct EpiBranch {
    const bf16_t* gates; unsigned char* Gout;
    DI void operator()(const f32x4 (&acc)[2][2][4][2], const Unit& u, int wr, int wc, int fr, int fq) const {
        const int row0 = u.pm * BM + wr * 64 + fr, col0 = u.aux * D + u.pn * BM + wc * 32 + 8 * fq;
#pragma unroll
        for (int ai = 0; ai < 2; ++ai)
#pragma unroll
            for (int m = 0; m < 4; ++m) { const size_t row = (size_t)(row0 + ai * HALF + m * 16);
#pragma unroll
                for (int bj = 0; bj < 2; ++bj) { const int col = col0 + bj * HALF;
                    const u32x4 gw = *(const u32x4*)(gates + row * 4096 + col); float g[8]; unpack8(gw, g);
                    const f32x4 v0 = acc[ai][bj][m][0], v1 = acc[ai][bj][m][1];
                    u32x2 w; w.x = pk4_fp8(v0[0] * g[0] * G8S, v0[1] * g[1] * G8S, v0[2] * g[2] * G8S, v0[3] * g[3] * G8S); w.y = pk4_fp8(v1[0] * g[4] * G8S, v1[1] * g[5] * G8S, v1[2] * g[6] * G8S, v1[3] * g[7] * G8S);
                    *(u32x2*)(Gout + row * 4096 + col) = w; } }
    }
};
struct EpiOut {
    const float* x; const float* ctx; bf16_t* xres; const float* mod; int layer;
    DI void operator()(const f32x4 (&acc)[2][2][4][2], const Unit& u, int wr, int wc, int fr, int fq) const {
        const int row0 = u.pm * BM + wr * 64 + fr, col0 = u.pn * BM + wc * 32 + 8 * fq;
#pragma unroll
        for (int ai = 0; ai < 2; ++ai)
#pragma unroll
            for (int m = 0; m < 4; ++m) { const int row = row0 + ai * HALF + m * 16; const int b = row / LTOK, pos = row - b * LTOK;
                const float* src = pos < CTX ? ctx + (size_t)(b * CTX + pos) * D : x + (size_t)(b * SEQ + pos - CTX) * D;
                const float* mg = mod + (size_t)(pos < CTX ? 8 : b) * 6144 + 2 * D;
#pragma unroll
                for (int bj = 0; bj < 2; ++bj) { const int col = col0 + bj * HALF;
                    f32x4 xi[2];
                    if (layer == 0) { xi[0] = *(const f32x4*)(src + col); xi[1] = *(const f32x4*)(src + col + 4); }
                    else { const u32x4 w = *(const u32x4*)(xres + (size_t)row * D + col); u32x2 lo, hi; lo.x = w.x; lo.y = w.y; hi.x = w.z; hi.y = w.w; xi[0] = unpack4(lo); xi[1] = unpack4(hi); }
                    const f32x4 v0 = xi[0] + *(const f32x4*)(mg + col) * acc[ai][bj][m][0], v1 = xi[1] + *(const f32x4*)(mg + col + 4) * acc[ai][bj][m][1];
                    u32x4 o; o.x = pk2(v0[0], v0[1]); o.y = pk2(v0[2], v0[3]); o.z = pk2(v1[0], v1[1]); o.w = pk2(v1[2], v1[3]);
                    *(u32x4*)(xres + (size_t)row * D + col) = o; } }
    }
};
struct EpiGU {
    const int* amap; const float* bgu; bf16_t* ybuf;
    DI void operator()(const f32x4 (&acc)[2][2][4][2], const Unit& u, int wr, int wc, int fr, int fq) const {
        const int e = u.aux, ff0 = u.pn * 128 + wc * 32 + 8 * fq;
        const float* bg = bgu + (size_t)e * 2048 + ff0;
        f32x4 bgv[2], buv[2];
#pragma unroll
        for (int n = 0; n < 2; ++n) { bgv[n] = *(const f32x4*)(bg + 4 * n); buv[n] = *(const f32x4*)(bg + 1024 + 4 * n); }
#pragma unroll
        for (int ai = 0; ai < 2; ++ai)
#pragma unroll
            for (int m = 0; m < 4; ++m) { const int rl = u.pm * BM + ai * HALF + wr * 64 + m * 16 + fr; const int a = amap[(size_t)e * AMAX + rl];
                float y[8];
#pragma unroll
                for (int n = 0; n < 2; ++n) { const f32x4 gt = acc[ai][0][m][n] + bgv[n], up = acc[ai][1][m][n] + buv[n];
#pragma unroll
                    for (int j = 0; j < 4; ++j) { const float g = fminf(gt[j], 7.f), uu = fminf(fmaxf(up[j], -7.f), 7.f); y[4 * n + j] = (uu + 1.f) * (g * sigmoidf_(1.702f * g)); } }
                *(u32x2*)((unsigned char*)ybuf + (size_t)a * D + ff0) = pack8_fp8(y); }
    }
};
struct EpiDown {
    const int* amap; const float* bdn; unsigned char* obuf;
    DI void operator()(const f32x4 (&acc)[2][2][4][2], const Unit& u, int wr, int wc, int fr, int fq) const {
        const int e = u.aux, col0 = u.pn * BM + wc * 32 + 8 * fq;
        f32x4 bv[2][2];
#pragma unroll
        for (int bj = 0; bj < 2; ++bj)
#pragma unroll
            for (int n = 0; n < 2; ++n) bv[bj][n] = *(const f32x4*)(bdn + (size_t)e * D + col0 + bj * HALF + 4 * n);
#pragma unroll
        for (int ai = 0; ai < 2; ++ai)
#pragma unroll
            for (int m = 0; m < 4; ++m) { const int rl = u.pm * BM + ai * HALF + wr * 64 + m * 16 + fr; const int a = amap[(size_t)e * AMAX + rl];
#pragma unroll
                for (int bj = 0; bj < 2; ++bj) { const f32x4 v0 = acc[ai][bj][m][0] + bv[bj][0], v1 = acc[ai][bj][m][1] + bv[bj][1];
                    u32x2 w; w.x = pk4_fp8(v0[0] * O8S, v0[1] * O8S, v0[2] * O8S, v0[3] * O8S); w.y = pk4_fp8(v1[0] * O8S, v1[1] * O8S, v1[2] * O8S, v1[3] * O8S);
                    *(u32x2*)(obuf + (size_t)a * D + col0 + bj * HALF) = w; } }
    }
};
}

struct Ctx {
    LAS unsigned char* lds; int tid, lane, wave, G, bid;
    const __attribute__((address_space(4))) cfp_t* in; float* out; unsigned char* ws;
};
#define WSP(T_, off) ((T_*)(F.ws + (off)))

struct TrJob { const float* W; unsigned char* WT; int K, N, k0, n0, mode, f8; };
constexpr int CS_WIN = 8 * 24, CS_WMG = 8 * 16, CS_WBR = 4 * 4 * 4, CS_WO = 8 * 4, CS_GU = NE * 8 * 8, CS_DN = NE * 8 * 4, CS_L = CS_WIN + CS_WMG + CS_WBR + CS_WO + CS_GU + CS_DN;
constexpr int CV_N0 = CS_WIN + CS_WMG, CV_N1 = 2 * CS_L - CV_N0;
DI void conv_job(const Ctx& F, int it, TrJob& t) {
    const int l = it / CS_L; int r = it % CS_L; int kb, nb;
    if (r < CS_WIN) { t.W = GIN(F.in, I_WIN) + (size_t)l * D * 6160; t.K = D; t.N = 6160; t.WT = (unsigned char*)(WSP(bf16_t, WS_W1T) + (size_t)l * NG1 * D); t.mode = 0; t.f8 = 0; kb = r / 24; nb = r % 24; }
    else if ((r -= CS_WIN) < CS_WMG) { t.W = GIN(F.in, I_WMG) + (size_t)l * D * 4096; t.K = D; t.N = 4096; t.WT = F.ws + WS_WMG8 + (size_t)l * 4096 * D; t.mode = 0; t.f8 = 1; kb = r / 16; nb = r % 16; }
    else if ((r -= CS_WMG) < CS_WBR) { const int n4 = r / 16, q = r % 16; t.W = GIN(F.in, I_WBR) + ((size_t)l * 4 + n4) * 512 * D; t.K = 512; t.N = D; t.WT = (unsigned char*)(WSP(bf16_t, WS_WBT) + ((size_t)l * 4 + n4) * D * 512); t.mode = 0; t.f8 = 0; kb = q / 4; nb = q % 4; }
    else if ((r -= CS_WBR) < CS_WO) { t.W = GIN(F.in, I_WOUT) + (size_t)l * D * D; t.K = D; t.N = D; t.WT = (unsigned char*)(WSP(bf16_t, WS_WOT) + (size_t)l * D * D); t.mode = 0; t.f8 = 0; kb = r / 4; nb = r % 4; }
    else if ((r -= CS_WO) < CS_GU) { const int e = r / 64, q = r % 64; t.W = GIN(F.in, I_WGU) + ((size_t)l * NE + e) * D * 2048; t.K = D; t.N = 2048; t.WT = F.ws + WS_WGU + ((size_t)l * NE + e) * 2048 * D; t.mode = 1; t.f8 = 1; kb = q / 8; nb = q % 8; }
    else { r -= CS_GU; const int e = r / 32, q = r % 32; t.W = GIN(F.in, I_WDN) + ((size_t)l * NE + e) * D * D; t.K = D; t.N = D; t.WT = F.ws + WS_WDN + ((size_t)l * NE + e) * D * D; t.mode = 0; t.f8 = 1; kb = q / 4; nb = q % 4; }
    t.k0 = kb * 128; t.n0 = nb * 256;
}
DI void st_fetch(const TrJob& t, f32x4 (&v)[16], int lane, int wave) {
    const float* src = t.W + (size_t)(t.k0 + wave) * t.N + t.n0 + 4 * lane;
#pragma unroll
    for (int r = 0; r < 16; ++r) v[r] = __builtin_nontemporal_load((const f32x4*)(src + (size_t)(8 * r) * t.N));
}
DI void st_emit(const TrJob& t, const f32x4 (&v)[16], LAS float* S, int lane, int wave) {
    __syncthreads();
#pragma unroll
    for (int r = 0; r < 16; ++r) { const int k = wave + 8 * r; *(LAS f32x4*)(S + k * 256 + 4 * (lane ^ ((k >> 4) & 7))) = v[r]; }
    __syncthreads();
    if (!t.f8) {
        const int c = lane & 15, nl = lane >> 4;
#pragma unroll
        for (int j = 0; j < 8; ++j) { const int nloc = 32 * wave + nl + 4 * j, n = t.n0 + nloc;
            const LAS float* sp = S + (8 * c) * 256 + 4 * ((nloc >> 2) ^ (c >> 1)) + (nloc & 3); u32x4 o;
            o.x = pk2(sp[0], sp[256]); o.y = pk2(sp[2 * 256], sp[3 * 256]); o.z = pk2(sp[4 * 256], sp[5 * 256]); o.w = pk2(sp[6 * 256], sp[7 * 256]);
            __builtin_nontemporal_store(o, (u32x4*)((bf16_t*)t.WT + (size_t)n * t.K + t.k0 + 8 * c)); }
    } else {
        const int c = lane & 7, nl = lane >> 3; const float sc = (float)(1 << FP8_WSHIFT);
#pragma unroll
        for (int j = 0; j < 4; ++j) { const int nloc = 32 * wave + nl + 8 * j, n = t.n0 + nloc;
            int drow = n; if (t.mode == 1) { const int ff = n & 1023; drow = (ff >> 7) * 256 + (n >= 1024 ? 128 : 0) + (ff & 127); }
            const LAS float* sp = S + (16 * c) * 256 + 4 * ((nloc >> 2) ^ c) + (nloc & 3); u32x4 o;
            o.x = pk4_fp8(sp[0] * sc, sp[256] * sc, sp[2 * 256] * sc, sp[3 * 256] * sc); o.y = pk4_fp8(sp[4 * 256] * sc, sp[5 * 256] * sc, sp[6 * 256] * sc, sp[7 * 256] * sc);
            o.z = pk4_fp8(sp[8 * 256] * sc, sp[9 * 256] * sc, sp[10 * 256] * sc, sp[11 * 256] * sc); o.w = pk4_fp8(sp[12 * 256] * sc, sp[13 * 256] * sc, sp[14 * 256] * sc, sp[15 * 256] * sc);
            __builtin_nontemporal_store(o, (u32x4*)(t.WT + (size_t)drow * t.K + t.k0 + 16 * c)); }
    }
}
DI void convert_range(const Ctx& F, int first, int a, int b, int nblk, int blk) {
    int lane_; asm volatile("v_mbcnt_lo_u32_b32 %0, -1, 0\n\tv_mbcnt_hi_u32_b32 %0, -1, %0" : "=v"(lane_)); const int lane = lane_;
    LAS float* S = (LAS float*)F.lds;
    TrJob cur, nxt; f32x4 v[16], vn[16];
    int j = a + blk;
    if (j < b) { conv_job(F, first + j, cur); st_fetch(cur, v, lane, F.wave); }
#pragma unroll 1
    for (; j < b; j += nblk) {
        const bool more = j + nblk < b;
        if (more) { conv_job(F, first + j + nblk, nxt); st_fetch(nxt, vn, lane, F.wave); }
        st_emit(cur, v, S, lane, F.wave);
        if (more) { cur = nxt;
#pragma unroll
            for (int i = 0; i < 16; ++i) v[i] = vn[i]; }
    }
    __syncthreads();
}
constexpr int CV_ITEM = 8, CV_NITEM = CV_N1 / CV_ITEM;
static_assert(CV_N1 % CV_ITEM == 0, "conversion items");
DI void phase_prep(const Ctx& F) {
    convert_range(F, 0, 0, CV_N0, F.G, F.bid);
    const int gt = F.bid * 512 + F.tid, NGT = F.G * 512;
    for (int i = gt; i < 256 * (D / 16); i += NGT) *(u32x4*)(F.ws + WS_HZ + (size_t)T * D + (size_t)i * 16) = (u32x4){0u, 0u, 0u, 0u};
    for (int i = gt; i < 2 * NE * AMAX; i += NGT) WSP(int, WS_AMAP)[i] = A_TOT;
    if (gt < 64) WSP(int, WS_CNT)[gt] = 0;
    for (int i = gt; i < 2 * 16 * D; i += NGT) { const int l = i / (16 * D), r = i % (16 * D), c = r / D, k = r % D; WSP(float, WS_WAB)[i] = GIN(F.in, I_WIN)[(size_t)l * D * 6160 + (size_t)k * 6160 + 6144 + c]; }
    for (int i = gt; i < 2 * NE * D; i += NGT) { const int l = i / (NE * D), r = i % (NE * D), e = r / D, k = r % D; WSP(float, WS_RWT)[i] = GIN(F.in, I_RW)[(size_t)l * D * NE + (size_t)k * NE + e]; }
    {
        float* rp = WSP(float, WS_ROPE);
        for (int i = gt; i < 2048 * 32; i += NGT) { const int t = i >> 5, f = i & 31; const float inv = powf(10000.f, -(float)(2 * f) / 64.f); float s, c; sincosf((float)t * inv, &s, &c); rp[i] = c; rp[2048 * 32 + i] = s; }
        float* rr = rp + 2 * 2048 * 32;
        for (int i = gt; i < 32 * 16; i += NGT) { const int t = i >> 4, f = i & 15; const float inv = powf(10000.f, -(float)(2 * f) / 32.f); float s, c; sincosf((float)t * inv, &s, &c); rr[i] = c; rr[512 + i] = s; }
        float* rc = rr + 1024;
        for (int i = gt; i < 64 * 16; i += NGT) { const int t = i >> 4, f = i & 15; const float inv = powf(10000.f, -(float)(2 * f) / 32.f); float s, c; sincosf((float)t * inv, &s, &c); rc[i] = c; rc[1024 + i] = s; }
    }
    __syncthreads();
    LAS float* sc = (LAS float*)F.lds;
    LAS float* red = (LAS float*)(F.lds + 40960);
    for (int i = F.tid; i < 9 * D; i += 512) { const int r = i >> 10, k = i & 1023; const float v = r < 8 ? GIN(F.in, I_C)[r * D + k] : GIN(F.in, I_CCTX)[k]; sc[i] = siluf_(v); }
    __syncthreads();
    for (int it = F.bid; it < 2 * 96; it += F.G) {
        const int l = it / 96, j0 = (it % 96) * 64;
        const float* W = GIN(F.in, I_WADA) + (size_t)l * D * 6144 + j0 + F.lane;
        float a[9];
#pragma unroll
        for (int r = 0; r < 9; ++r) a[r] = 0.f;
        const int kb = F.wave * 128;
#pragma unroll 4
        for (int k = 0; k < 128; ++k) { const float w = W[(size_t)(kb + k) * 6144];
#pragma unroll
            for (int r = 0; r < 9; ++r) a[r] += sc[r * D + kb + k] * w; }
#pragma unroll
        for (int r = 0; r < 9; ++r) red[(F.wave * 9 + r) * 64 + F.lane] = a[r];
        __syncthreads();
        for (int i = F.tid; i < 9 * 64; i += 512) { const int r = i >> 6, j = i & 63; float s = GIN(F.in, I_BADA)[(size_t)l * 6144 + j0 + j];
#pragma unroll
            for (int w = 0; w < 8; ++w) s += red[(w * 9 + r) * 64 + j];
            WSP(float, WS_MOD)[((size_t)l * 9 + r) * 6144 + j0 + j] = s; }
        __syncthreads();
    }
}

DI void moe_comb_row(const Ctx& F, int l, int m, f32x4 (&cv)[4]) {
    const float* gb = WSP(float, WS_GATEB) + (size_t)l * A_TOT + (size_t)m * 4;
    const unsigned char* ob = F.ws + WS_OBUF + (size_t)m * 4 * D;
#pragma unroll
    for (int j = 0; j < 4; ++j) cv[j] = (f32x4){0.f, 0.f, 0.f, 0.f};
#pragma unroll
    for (int k = 0; k < 4; ++k) { const float g = gb[k] * (1.f / O8S);
#pragma unroll
        for (int j = 0; j < 4; ++j) { const unsigned w = *(const unsigned*)(ob + (size_t)k * D + 4 * F.lane + 256 * j);
            const f32x2 lo = __builtin_amdgcn_cvt_pk_f32_fp8((int)w, false), hi = __builtin_amdgcn_cvt_pk_f32_fp8((int)w, true);
            cv[j][0] += g * lo[0]; cv[j][1] += g * lo[1]; cv[j][2] += g * hi[0]; cv[j][3] += g * hi[1]; } }
}
DI void phase_norm(const Ctx& F, int l) {
    const int gw = F.bid * 8 + F.wave, NGW = F.G * 8, lane = F.lane;
    const float* mod = WSP(float, WS_MOD) + (size_t)l * 9 * 6144;
    const float* gain = GIN(F.in, I_NMIX) + (size_t)l * D;
    LAS float* wab = (LAS float*)F.lds;
    { const f32x4* src = (const f32x4*)(WSP(float, WS_WAB) + (size_t)l * 16 * D); f32x4 tmp[8];
#pragma unroll
        for (int i = 0; i < 8; ++i) tmp[i] = src[F.tid + 512 * i];
#pragma unroll
        for (int i = 0; i < 8; ++i) *(LAS f32x4*)(wab + 4 * (F.tid + 512 * i)) = tmp[i]; }
    __syncthreads();
    constexpr int RT = 3;
    for (int m0 = gw; m0 < T; m0 += RT * NGW) {
        f32x4 v[RT][4]; int mm[RT];
#pragma unroll
        for (int t = 0; t < RT; ++t) { const int mq = m0 + t * NGW; mm[t] = mq; const int m = mq < T ? mq : m0;
            const int b = m / LTOK, pos = m - b * LTOK, mr = pos < CTX ? 8 : b;
            if (l == 0) { const float* src = pos < CTX ? GIN(F.in, I_CTX) + (size_t)(b * CTX + pos) * D : GIN(F.in, I_X) + (size_t)(b * SEQ + pos - CTX) * D;
#pragma unroll
                for (int j = 0; j < 4; ++j) v[t][j] = *(const f32x4*)(src + 4 * lane + 256 * j);
            } else if (mq < T) {
                bf16_t* xr = WSP(bf16_t, WS_XRES) + (size_t)m * D; f32x4 cv[4]; moe_comb_row(F, 0, m, cv);
                const float* m5 = WSP(float, WS_MOD) + (size_t)mr * 6144 + 5 * D;
#pragma unroll
                for (int j = 0; j < 4; ++j) { const int col = 4 * lane + 256 * j; v[t][j] = unpack4(*(const u32x2*)(xr + col)) + *(const f32x4*)(m5 + col) * cv[j]; *(u32x2*)(xr + col) = pack4(v[t][j]); }
            } else {
#pragma unroll
                for (int j = 0; j < 4; ++j) v[t][j] = (f32x4){0.f, 0.f, 0.f, 0.f}; }
            float ss = 0.f;
#pragma unroll
            for (int j = 0; j < 4; ++j) ss += v[t][j][0] * v[t][j][0] + v[t][j][1] * v[t][j][1] + v[t][j][2] * v[t][j][2] + v[t][j][3] * v[t][j][3];
            const float rstd = rsqrtf(wave_sum(ss) * (1.f / D) + EPS);
            bf16_t* o = WSP(bf16_t, WS_HZ) + (size_t)m * D; unsigned char* o8 = F.ws + WS_HZ8 + (size_t)m * D;
#pragma unroll
            for (int j = 0; j < 4; ++j) { const int col = 4 * lane + 256 * j; const f32x4 g = *(const f32x4*)(gain + col), sh = *(const f32x4*)(mod + (size_t)mr * 6144 + col), sc = *(const f32x4*)(mod + (size_t)mr * 6144 + D + col);
                v[t][j] = v[t][j] * rstd * g * (sc + 1.f) + sh;
                if (mq < T) { u32x2 w; w.x = pk2(v[t][j][0], v[t][j][1]); w.y = pk2(v[t][j][2], v[t][j][3]); *(u32x2*)(o + col) = w; *(unsigned*)(o8 + col) = pk4_fp8(v[t][j][0], v[t][j][1], v[t][j][2], v[t][j][3]); } } }
        float abv[RT];
#pragma unroll
        for (int t = 0; t < RT; ++t) abv[t] = 0.f;
#pragma unroll 1
        for (int g = 0; g < 2; ++g) {
            float ab[RT][8];
#pragma unroll
            for (int c = 0; c < 8; ++c) { f32x4 w[4];
#pragma unroll
                for (int j = 0; j < 4; ++j) w[j] = *(const LAS f32x4*)(wab + (g * 8 + c) * D + 4 * lane + 256 * j);
#pragma unroll
                for (int t = 0; t < RT; ++t) { float a = 0.f;
#pragma unroll
                    for (int j = 0; j < 4; ++j) a += v[t][j][0] * w[j][0] + v[t][j][1] * w[j][1] + v[t][j][2] * w[j][2] + v[t][j][3] * w[j][3];
                    ab[t][c] = a; } }
#pragma unroll
            for (int t = 0; t < RT; ++t) {
#pragma unroll
                for (int c = 0; c < 8; ++c) ab[t][c] += xshfl<32>(ab[t][c]);
                { const bool hi = (lane >> 4) & 1;
#pragma unroll
                    for (int e = 0; e < 4; ++e) { const float snd = hi ? ab[t][e] : ab[t][e + 4], kp = hi ? ab[t][e + 4] : ab[t][e]; ab[t][e] = kp + xshfl<16>(snd); } }
                { const bool hi = (lane >> 3) & 1;
#pragma unroll
                    for (int e = 0; e < 2; ++e) { const float snd = hi ? ab[t][e] : ab[t][e + 2], kp = hi ? ab[t][e + 2] : ab[t][e]; ab[t][e] = kp + xshfl<8>(snd); } }
                { const bool hi = (lane >> 2) & 1; const float snd = hi ? ab[t][0] : ab[t][1], kp = hi ? ab[t][1] : ab[t][0]; ab[t][0] = kp + xshfl<4>(snd); }
                ab[t][0] += xshfl<2>(ab[t][0]); ab[t][0] += xshfl<1>(ab[t][0]);
                if ((lane & 1) == g) abv[t] = ab[t][0]; }
        }
#pragma unroll
        for (int t = 0; t < RT; ++t)
            if (mm[t] < T && lane < 32 && (lane & 2) == 0) WSP(float, WS_AB)[(size_t)mm[t] * 16 + 8 * (lane & 1) + 4 * ((lane >> 4) & 1) + 2 * ((lane >> 3) & 1) + ((lane >> 2) & 1)] = abv[t];
    }
}

DI int scan_pos(int s, int dir) { return dir == 0 ? s : (s < CTX ? CTX - 1 - s : LTOK - 1 - (s - CTX)); }
typedef float f32x16 __attribute__((ext_vector_type(16)));
typedef short s16x4 __attribute__((ext_vector_type(4)));
DI int swz16(int row) { return ((row & 3) << 2) | ((row >> 2) & 3); }
DI void glds16(const void* g, LAS void* l) { __builtin_amdgcn_global_load_lds((const unsigned*)g, (LAS unsigned*)l, 16, 0, 0); }
DI s16x4 tr_read(const LAS unsigned char* p) { return __builtin_amdgcn_ds_read_tr16_b64_v4i16((LAS s16x4*)p); }
struct NoMask { DI void apply(f32x16&, int, int) const {} };
struct NaMask {
    const LAS float* tb; int c0; bool on;
    DI void apply(f32x16& S, int sub, int h) const {
        if (!on) return;
#pragma unroll
        for (int i = 0; i < 16; ++i) { const int kc = sub * 32 + (i & 3) + 8 * (i >> 2) + 4 * h; const float bias = tb[kc]; S[i] = ((unsigned)(kc - c0) < 16u) ? S[i] + bias : -INFINITY; }
    }
};
template <int DVB> struct AttnAddr { int k[4]; int v[2][DVB]; };
template <int DVB> DI void attn_addr(AttnAddr<DVB>& A, const int kch, const int vch, const int lane) {
    const int r = lane & 31, h = lane >> 5, q = (lane & 15) >> 2, p = lane & 3, blk = (lane >> 4) & 1;
#pragma unroll
    for (int s = 0; s < 4; ++s) A.k[s] = r * 256 + (((kch + 2 * s + h) ^ swz16(r)) << 4);
#pragma unroll
    for (int hi = 0; hi < 2; ++hi) { const int row = 8 * hi + 4 * h + q;
#pragma unroll
        for (int d = 0; d < DVB; ++d) A.v[hi][d] = row * 256 + (((vch + 4 * d + 2 * blk + (p >> 1)) ^ swz16(row)) << 4) + (p & 1) * 8; }
}
DI float xhalf_max(float v) {
    const auto r2 = __builtin_amdgcn_permlane32_swap(__float_as_uint(v), __float_as_uint(v), false, false);
    return fmaxf(__uint_as_float(r2[0]), __uint_as_float(r2[1]));
}
template <int DVB, class Mask>
DI void attn_tile(const LAS unsigned char* kt, const LAS unsigned char* vt, const AttnAddr<DVB>& A, const bf16x8 (&qf)[4], f32x16 (&O)[DVB], float& m, float& l, const Mask& mk, const int lane) {
    const int h = lane >> 5;
    f32x16 S[2];
#pragma unroll
    for (int sub = 0; sub < 2; ++sub) {
#pragma unroll
        for (int i = 0; i < 16; ++i) S[sub][i] = 0.f;
#pragma unroll
        for (int s = 0; s < 4; ++s) { const bf16x8 a = *(const LAS bf16x8*)(kt + A.k[s] + sub * 8192); S[sub] = __builtin_amdgcn_mfma_f32_32x32x16_bf16(a, qf[s], S[sub], 0, 0, 0); }
    }
    mk.apply(S[0], 0, h); mk.apply(S[1], 1, h);
    float tm = fmaxf(S[0][0], S[1][0]);
#pragma unroll
    for (int i = 1; i < 16; ++i) tm = fmaxf(tm, fmaxf(S[0][i], S[1][i]));
    tm = xhalf_max(tm);
    const float mn = fmaxf(m, tm);
    float ps = 0.f;
#pragma unroll
    for (int sub = 0; sub < 2; ++sub)
#pragma unroll
        for (int i = 0; i < 16; ++i) { S[sub][i] = __builtin_amdgcn_exp2f(S[sub][i] - mn); ps += S[sub][i]; }
    if (__builtin_amdgcn_ballot_w64(mn != m) != 0ull) {
        const float corr = __builtin_amdgcn_exp2f(m - mn); m = mn; l *= corr;
#pragma unroll
        for (int d = 0; d < DVB; ++d)
#pragma unroll
            for (int i = 0; i < 16; ++i) O[d][i] *= corr; }
    l += ps;
    bf16x8 pf[4];
#pragma unroll
    for (int s4 = 0; s4 < 4; ++s4) { const int sub = s4 >> 1, o = 8 * (s4 & 1); u32x4 w; w.x = cvt_pk_bf16(S[sub][o], S[sub][o + 1]); w.y = cvt_pk_bf16(S[sub][o + 2], S[sub][o + 3]); w.z = cvt_pk_bf16(S[sub][o + 4], S[sub][o + 5]); w.w = cvt_pk_bf16(S[sub][o + 6], S[sub][o + 7]);
        pf[s4] = __builtin_bit_cast(bf16x8, w); }
#pragma unroll
    for (int s4 = 0; s4 < 4; ++s4) {
#pragma unroll
        for (int d = 0; d < DVB; ++d) {
            const s16x4 lo = tr_read(vt + A.v[0][d] + s4 * 4096), hi = tr_read(vt + A.v[1][d] + s4 * 4096);
            O[d] = __builtin_amdgcn_mfma_f32_32x32x16_bf16(__builtin_shufflevector(lo, hi, 0, 1, 2, 3, 4, 5, 6, 7), pf[s4], O[d], 0, 0, 0); }
    }
}
DI void diff_item(const Ctx& F, int l, int b, int h, int q0, int nkeys) {
    const int lane = F.lane, comp = F.wave & 1, qsub = F.wave >> 1, r = lane & 31, hh = lane >> 5;
    const bf16_t* Pb = WSP(bf16_t, WS_P) + (size_t)b * LTOK * PW;
    bf16x8 qf[4];
    { const bf16_t* qp = Pb + (size_t)(q0 + qsub * 32 + r) * PW + C_DFQ + h * 128 + comp * 64 + 8 * hh;
#pragma unroll
        for (int s = 0; s < 4; ++s) qf[s] = *(const bf16x8*)(qp + 16 * s); }
    f32x16 O[4];
#pragma unroll
    for (int d = 0; d < 4; ++d)
#pragma unroll
        for (int i = 0; i < 16; ++i) O[d][i] = 0.f;
    float m = -1e30f, lsum = 0.f;
    AttnAddr<4> AD; attn_addr<4>(AD, comp * 8, 0, lane);
    const int nt = nkeys / 64;
    auto stage = [&](int t) {
        LAS unsigned char* kt = F.lds + (t & 1) * 16384; LAS unsigned char* vt = F.lds + 32768 + (t & 1) * 16384;
#pragma unroll
        for (int i = 0; i < 2; ++i) { const int pp = F.tid + 512 * i, row = pp >> 4, c = (pp & 15) ^ swz16(row);
            const bf16_t* src = Pb + (size_t)(t * 64 + row) * PW + h * 128 + c * 8;
            glds16(src + C_DFK, kt + (F.wave * 64 + 512 * i) * 16); glds16(src + C_DFV, vt + (F.wave * 64 + 512 * i) * 16); } };
    stage(0);
    for (int t = 0; t < nt; ++t) {
        asm volatile("s_waitcnt vmcnt(0)" ::: "memory"); __syncthreads();
        if (t + 1 < nt) stage(t + 1);
        attn_tile<4>(F.lds + (t & 1) * 16384, F.lds + 32768 + (t & 1) * 16384, AD, qf, O, m, lsum, NoMask{}, lane);
    }
    const float lt = lsum + xshfl<32>(lsum), inv = 1.f / lt;
    __syncthreads();
    LAS float* ex = (LAS float*)F.lds + qsub * 4096;
    if (comp == 1) {
#pragma unroll
        for (int d = 0; d < 4; ++d)
#pragma unroll
            for (int i = 0; i < 16; ++i) ex[(d * 16 + i) * 64 + lane] = O[d][i] * inv; }
    __syncthreads();
    if (comp == 0) {
        const float* lp = GIN(F.in, I_DFLAM) + (size_t)l * 4 * 64;
        float s01 = lp[lane] * lp[64 + lane], s23 = lp[128 + lane] * lp[192 + lane]; s01 = wave_sum(s01); s23 = wave_sum(s23);
        const float lam_init = 0.8f - 0.6f * __expf(-0.3f * (float)l), lam = __expf(s01) - __expf(s23) + lam_init;
        float ss = 0.f;
#pragma unroll
        for (int d = 0; d < 4; ++d)
#pragma unroll
            for (int i = 0; i < 16; ++i) { const float v = O[d][i] * inv - lam * ex[(d * 16 + i) * 64 + lane]; O[d][i] = v; ss += v * v; }
        ss += xshfl<32>(ss);
        const float rn = rsqrtf(ss * (1.f / 128.f) + EPS) * (1.f - lam_init);
        const float* sg = GIN(F.in, I_DFSUB) + (size_t)l * 128;
        bf16_t* yp = WSP(bf16_t, WS_YS) + (size_t)(b * LTOK + q0 + qsub * 32 + r) * YSW + 1024 + h * 128;
#pragma unroll
        for (int d = 0; d < 4; ++d)
#pragma unroll
            for (int g = 0; g < 4; ++g) { const int dv = d * 32 + 8 * g + 4 * hh; const f32x4 gg = *(const f32x4*)(sg + dv);
                u32x2 w; w.x = pk2(O[d][4 * g] * rn * gg[0], O[d][4 * g + 1] * rn * gg[1]); w.y = pk2(O[d][4 * g + 2] * rn * gg[2], O[d][4 * g + 3] * rn * gg[3]); *(u32x2*)(yp + dv) = w; }
    }
    __syncthreads();
}
DI void na_item(const Ctx& F, int l, int b, int h, int g, bool ctxq) {
    const int lane = F.lane, rr = F.wave >> 1, qh = F.wave & 1, r = lane & 31, hh = lane >> 5;
    const bf16_t* Pb = WSP(bf16_t, WS_P) + (size_t)b * LTOK * PW;
    LAS float* tbl = (LAS float*)(F.lds + 65536 + 1024);
    if (!ctxq) { for (int i = F.tid; i < 15 * 31; i += 512) tbl[i] = GIN(F.in, I_NARPB)[((size_t)l * 8 + h) * 465 + i] * 1.4426950408889634f; }
    const int grow = 4 * g + rr, c = qh * 32 + r;
    const int qpos = ctxq ? F.wave * 32 + r : CTX + grow * 64 + c;
    bf16x8 qf[4];
    { const bf16_t* qp = Pb + (size_t)qpos * PW + C_NAQ + h * 64 + 8 * hh;
#pragma unroll
        for (int s = 0; s < 4; ++s) qf[s] = *(const bf16x8*)(qp + 16 * s); }
    f32x16 O[2];
#pragma unroll
    for (int d = 0; d < 2; ++d)
#pragma unroll
        for (int i = 0; i < 16; ++i) O[d][i] = 0.f;
    float m = -1e30f, lsum = 0.f;
    AttnAddr<2> AD; attn_addr<2>(AD, 0, 8, lane);
    const int kr_lo = ctxq ? 0 : min(max(4 * g - 4, 0), GRID_R - 8), kr_hi = ctxq ? -1 : min(max(4 * g - 1, 0), GRID_R - 8) + 7;
    const int ngrid = kr_hi - kr_lo + 1, nt = ngrid + 4;
    const int r0 = min(max(grow - 4, 0), GRID_R - 8), c0 = min(max(c - 8, 0), GRID_W - 16);
    auto stage = [&](int t) {
        LAS unsigned char* kt = F.lds + (t & 1) * 16384;
        const int krow0 = t < ngrid ? CTX + (kr_lo + t) * 64 : (t - ngrid) * 64;
#pragma unroll
        for (int i = 0; i < 2; ++i) { const int pp = F.tid + 512 * i, row = pp >> 4, cc = (pp & 15) ^ swz16(row);
            const bf16_t* src = Pb + (size_t)(krow0 + row) * PW + h * 64 + (cc < 8 ? C_NAK + cc * 8 : C_NAV + (cc - 8) * 8);
            glds16(src, kt + (F.wave * 64 + 512 * i) * 16); } };
    stage(0);
    for (int t = 0; t < nt; ++t) {
        asm volatile("s_waitcnt vmcnt(0)" ::: "memory"); __syncthreads();
        if (t + 1 < nt) stage(t + 1);
        const LAS unsigned char* kt = F.lds + (t & 1) * 16384;
        if (t < ngrid) { const int kr = kr_lo + t;
            if (kr >= r0 && kr < r0 + 8) { NaMask mk{tbl + (kr - grow + 7) * 31 + 15 - c, c0, true}; attn_tile<2>(kt, kt, AD, qf, O, m, lsum, mk, lane); } }
        else attn_tile<2>(kt, kt, AD, qf, O, m, lsum, NoMask{}, lane);
    }
    const float lt = lsum + xshfl<32>(lsum), inv = 1.f / lt;
    bf16_t* yp = WSP(bf16_t, WS_YS) + (size_t)(b * LTOK + qpos) * YSW + h * 64;
#pragma unroll
    for (int d = 0; d < 2; ++d)
#pragma unroll
        for (int gq = 0; gq < 4; ++gq) { const int dv = d * 32 + 8 * gq + 4 * hh;
            u32x2 w; w.x = pk2(O[d][4 * gq] * inv, O[d][4 * gq + 1] * inv); w.y = pk2(O[d][4 * gq + 2] * inv, O[d][4 * gq + 3] * inv); *(u32x2*)(yp + dv) = w; }
    __syncthreads();
}
DI int tpos(int row, int ch) { return row * 256 + ((ch ^ swz16(row)) << 4); }
DI float wave_incl_scan(float v, int lane) {
#pragma unroll
    for (int o = 1; o < 64; o <<= 1) { const float t = __shfl_up(v, o); if (lane >= o) v += t; }
    return v;
}
DI int ppos(int row, int ch) { return row * 272 + ch * 16; }
DI void prep_chunk(const Ctx& F, int l, int it, bool valid, LAS unsigned char* gl, LAS float* sm  ) {
    int lane_ = F.lane; asm volatile("" : "+v"(lane_));
    const int lane = lane_, gw = F.wave & 3, gt = (F.wave & 3) * 64 + lane, r = lane & 31, h = lane >> 5, q = (lane & 15) >> 2, p = lane & 3, blk = (lane >> 4) & 1;
    const int NH = NBATCH * 4 * NCHUNK; const int br = it < NH ? 1 : 0; int x = it < NH ? it : it - NH; const int tc = x % NCHUNK; x /= NCHUNK; const int hd = x & 3, b = x >> 2, dir = F.wave >> 2;
    const int c = dir == 0 ? tc : (tc < 4 ? 3 - tc : 39 - tc);
    const int seq = ((br * 8 + b) * 4 + hd) * 2 + dir, ci = seq * NCHUNK + c;
    LAS unsigned char* KQ = gl; LAS unsigned char* VT = gl + 17408; LAS float* Lm = (LAS float*)(gl + 34816); LAS unsigned char* TT = gl + 51200;
    unsigned char* img = F.ws + WS_SEQT + (size_t)ci * 32768; bf16_t* UT = (bf16_t*)(F.ws + WS_SEQU + (size_t)ci * 16384);
    const bf16_t* Pw = WSP(bf16_t, WS_P);
#pragma unroll
    for (int i = 0; i < 2; ++i) { const int pp = F.wave * 64 + lane + 512 * i, row = pp >> 4, ch = pp & 15; const int pos = tc * 64 + row, m = b * LTOK + pos;
        const bool lat = pos >= CTX; const int li = pos - CTX;
        float kq[8], vv[8];
        if (br == 0) {
            const bf16_t* prow = Pw + (size_t)m * PW; const int cq = ch & 7, base = ch < 8 ? C_RK + hd * 64 : C_RQ + hd * 64;
            unpack8(*(const u32x4*)(prow + base + cq * 8), kq);
            { float pr[8]; unpack8(*(const u32x4*)(prow + base + (cq ^ 4) * 8), pr); const bool x1 = cq < 4; const float* ct = WSP(float, WS_ROPE) + (lat ? li : 0) * 32 + (cq & 3) * 8; const float* st = ct + 2048 * 32;
#pragma unroll
                for (int j = 0; j < 8; ++j) { const float cs = lat ? ct[j] : 1.f, sn = lat ? st[j] : 0.f; kq[j] = x1 ? kq[j] * cs - pr[j] * sn : kq[j] * cs + pr[j] * sn; } }
            if (ch < 8) {
#pragma unroll
                for (int j = 0; j < 8; ++j) kq[j] *= 0.125f; }
            unpack8(*(const u32x4*)(prow + C_RV + hd * 128 + ch * 8), vv);
        } else {
            const int segpos = lat ? li : pos, seglen = lat ? SEQ : CTX;
            const int chq = ch < 8 ? 256 + hd * 64 + ch * 8 : hd * 64 + (ch - 8) * 8, chv = 512 + hd * 128 + ch * 8;
            const float* cw = GIN(F.in, I_DNCONV) + (size_t)l * 5 * 1024;
#pragma unroll
            for (int j = 0; j < 8; ++j) { kq[j] = 0.f; vv[j] = 0.f; }
#pragma unroll
            for (int tp = 0; tp < 5; ++tp) { const int sp = segpos + tp - 2; const bool ok = sp >= 0 && sp < seglen; const float zf = ok ? 1.f : 0.f;
                const bf16_t* prow = Pw + (size_t)(ok ? m + tp - 2 : m) * PW + C_DNQ; float x[8], y[8]; unpack8(*(const u32x4*)(prow + chq), x); unpack8(*(const u32x4*)(prow + chv), y);
                const f32x4 a0 = *(const f32x4*)(cw + tp * 1024 + chq) * zf, a1 = *(const f32x4*)(cw + tp * 1024 + chq + 4) * zf, b0 = *(const f32x4*)(cw + tp * 1024 + chv) * zf, b1 = *(const f32x4*)(cw + tp * 1024 + chv + 4) * zf;
#pragma unroll
                for (int j = 0; j < 4; ++j) { kq[j] += x[j] * a0[j]; kq[4 + j] += x[4 + j] * a1[j]; vv[j] += y[j] * b0[j]; vv[4 + j] += y[4 + j] * b1[j]; } }
            float ss = 0.f;
#pragma unroll
            for (int j = 0; j < 8; ++j) { kq[j] = siluf_(kq[j]); vv[j] = siluf_(vv[j]); ss += kq[j] * kq[j]; }
            ss += xshfl<1>(ss); ss += xshfl<2>(ss); ss += xshfl<4>(ss);
            const float rn = rsqrtf(ss + EPS) * (ch < 8 ? 1.f : 0.125f);
#pragma unroll
            for (int j = 0; j < 8; ++j) kq[j] *= rn;
        }
        const u32x4 wk = pack8(kq), wv = pack8(vv);
        *(LAS u32x4*)(F.lds + ppos(row, ch)) = wk; *(LAS u32x4*)(F.lds + 17408 + ppos(row, ch)) = wv;
        *(LAS u32x4*)(F.lds + 69632 + ppos(63 - row, ch)) = wk; *(LAS u32x4*)(F.lds + 69632 + 17408 + ppos(63 - row, ch)) = wv; }
    if (gw == 0) { const int m = b * LTOK + scan_pos(c * 64 + lane, dir); float g, be;
        if (br == 0) { g = __logf(sigmoidf_(GIN(F.in, I_RETDEC)[(l * 2 + dir) * 4 + hd])); be = 1.f; }
        else { const float av = WSP(float, WS_AB)[(size_t)m * 16 + dir * 4 + hd], bv = WSP(float, WS_AB)[(size_t)m * 16 + 8 + dir * 4 + hd];
            const float xx = av + GIN(F.in, I_DNDT)[l * 8 + dir * 4 + hd]; const float sp = xx > 20.f ? xx : log1pf(__expf(xx));
            g = -__expf(GIN(F.in, I_DNALOG)[l * 8 + dir * 4 + hd]) * sp; be = sigmoidf_(bv); }
        const float gc = wave_incl_scan(g, lane); sm[lane] = gc; sm[64 + lane] = be;
        if (lane == 63 && valid) WSP(float, WS_SEQG)[ci] = __expf(gc); }
    __syncthreads();
    const int rl = (gw + 2 * (F.wave >> 2)) & 3;
    if (rl < 3) {
        const int jb = rl == 2 ? 1 : 0, ib = rl == 0 ? 0 : 1;
        f32x16 aq, ak;
#pragma unroll
        for (int i = 0; i < 16; ++i) { aq[i] = 0.f; ak[i] = 0.f; }
#pragma unroll
        for (int s = 0; s < 4; ++s) { const bf16x8 a = *(const LAS bf16x8*)(KQ + ppos(jb * 32 + r, 2 * s + h));
            const bf16x8 bq = *(const LAS bf16x8*)(KQ + ppos(ib * 32 + r, 8 + 2 * s + h)); aq = __builtin_amdgcn_mfma_f32_32x32x16_bf16(a, bq, aq, 0, 0, 0);
            if (br == 1) { const bf16x8 bk = *(const LAS bf16x8*)(KQ + ppos(ib * 32 + r, 2 * s + h)); ak = __builtin_amdgcn_mfma_f32_32x32x16_bf16(a, bk, ak, 0, 0, 0); } }
        const int irow = ib * 32 + r; const float gci = sm[irow], bi = sm[64 + irow];
#pragma unroll
        for (int g = 0; g < 4; ++g) { const int j0 = jb * 32 + 8 * g + 4 * h; float qv[4], lv[4];
#pragma unroll
            for (int jj = 0; jj < 4; ++jj) { const int j = j0 + jj; const float dec = __expf(gci - sm[j]); qv[jj] = j <= irow ? aq[4 * g + jj] * dec : 0.f; lv[jj] = j < irow ? ak[4 * g + jj] * dec * bi : 0.f; }
            if (valid) { u32x2 w; w.x = pk2(qv[0], qv[1]); w.y = pk2(qv[2], qv[3]); *(u32x2*)(img + 16384 + tpos(irow, j0 >> 3) + (j0 & 7) * 2) = w; }
            if (br == 1) *(LAS f32x4*)(Lm + irow * 64 + j0) = (f32x4){lv[0], lv[1], lv[2], lv[3]}; }
    } else {
        const float gcl = sm[63];
#pragma unroll
        for (int i = 0; i < 16; ++i) { const int pp = lane + 64 * i, row = pp >> 4, ch = pp & 15;
            float f[8]; unpack8(*(const LAS u32x4*)(KQ + ppos(row, ch)), f); const float sc = ch < 8 ? __expf(gcl - sm[row]) : __expf(sm[row]);
#pragma unroll
            for (int j = 0; j < 8; ++j) f[j] *= sc;
            if (valid) *(u32x4*)(img + (ch < 8 ? 16384 + tpos(row, 8 + ch) : tpos(row, ch))) = pack8(f); }
    }
    if (br == 0) {
#pragma unroll
        for (int n = 0; n < 8; ++n) { const s16x4 t = tr_read(VT + ppos(8 * n + 4 * h + q, 4 * gw + 2 * blk + (p >> 1)) + (p & 1) * 8);
            if (valid) *(s16x4*)(UT + (size_t)(gw * 32 + r) * 64 + 8 * n + 4 * h) = t; }
    }
    __syncthreads();
    if (br == 1) {
        if (rl < 2) {
            const int o = 32 * rl, c = lane & 31;
            float t[32];
#pragma unroll
            for (int g = 0; g < 8; ++g) {
                f32x4 lv[4][8];
#pragma unroll
                for (int r4 = 0; r4 < 4; ++r4)
#pragma unroll
                    for (int q4 = 0; q4 <= g; ++q4) lv[r4][q4] = *(const LAS f32x4*)(Lm + (o + 4 * g + r4) * 64 + o + 4 * q4);
#pragma unroll
                for (int r4 = 0; r4 < 4; ++r4) { const int i = 4 * g + r4; float a4[4] = {(i == c) ? 1.f : 0.f, 0.f, 0.f, 0.f};
#pragma unroll
                    for (int q4 = 0; q4 <= g; ++q4)
#pragma unroll
                        for (int jj = 0; jj < 4; ++jj) if (4 * q4 + jj < i) a4[jj] -= lv[r4][q4][jj] * t[4 * q4 + jj];
                    t[i] = (a4[0] + a4[1]) + (a4[2] + a4[3]); } }
            const float be = sm[64 + o + c], beg = be * __expf(sm[o + c]);
            if (lane < 32) {
#pragma unroll
                for (int i = 0; i < 32; ++i) { *(LAS bf16_t*)(TT + (o + i) * 272 + (o + c) * 2) = (bf16_t)f2bf(t[i] * be); *(LAS bf16_t*)(TT + (o + i) * 272 + 128 + (o + c) * 2) = (bf16_t)f2bf(t[i] * beg);
                    *(LAS bf16_t*)(KQ + (o + i) * 272 + 128 + c * 2) = (bf16_t)f2bf(t[i]); }
            } else if (rl == 0) {
#pragma unroll
                for (int i = 0; i < 32; ++i) { *(LAS bf16_t*)(TT + i * 272 + (32 + c) * 2) = 0; *(LAS bf16_t*)(TT + i * 272 + 128 + (32 + c) * 2) = 0; }
            }
        } else if (rl == 3) {
#pragma unroll
            for (int k2 = 0; k2 < 2; ++k2) { const int task = lane + 64 * k2, ip = task >> 2, j0 = (task & 3) * 8;
                const f32x4 x0 = *(const LAS f32x4*)(Lm + (32 + ip) * 64 + j0), x1 = *(const LAS f32x4*)(Lm + (32 + ip) * 64 + j0 + 4);
                u32x4 w; w.x = pk2(x0[0], x0[1]); w.y = pk2(x0[2], x0[3]); w.z = pk2(x1[0], x1[1]); w.w = pk2(x1[2], x1[3]);
                *(LAS u32x4*)(KQ + ip * 272 + 192 + j0 * 2) = w; }
        }
        __syncthreads();
        if (rl == 2) {
            f32x16 m1, m2;
#pragma unroll
            for (int i = 0; i < 16; ++i) { m1[i] = 0.f; m2[i] = 0.f; }
#pragma unroll
            for (int s2 = 0; s2 < 2; ++s2) {
                const bf16x8 a = *(const LAS bf16x8*)(KQ + r * 272 + 192 + (2 * s2 + h) * 16);
                const int ch = 8 + 2 * blk + (p >> 1);
                const s16x4 lo = tr_read(KQ + ppos(16 * s2 + 8 * h + q, ch) + (p & 1) * 8), hi = tr_read(KQ + ppos(16 * s2 + 8 * h + 4 + q, ch) + (p & 1) * 8);
                m1 = __builtin_amdgcn_mfma_f32_32x32x16_bf16(a, __builtin_shufflevector(lo, hi, 0, 1, 2, 3, 4, 5, 6, 7), m1, 0, 0, 0); }
#pragma unroll
            for (int s2 = 0; s2 < 2; ++s2) {
                u32x4 w; w.x = cvt_pk_bf16(m1[8 * s2], m1[8 * s2 + 1]); w.y = cvt_pk_bf16(m1[8 * s2 + 2], m1[8 * s2 + 3]); w.z = cvt_pk_bf16(m1[8 * s2 + 4], m1[8 * s2 + 5]); w.w = cvt_pk_bf16(m1[8 * s2 + 6], m1[8 * s2 + 7]);
                const s16x4 lo = *(const LAS s16x4*)(KQ + (32 + r) * 272 + 128 + (2 * s2) * 16 + 8 * h), hi = *(const LAS s16x4*)(KQ + (32 + r) * 272 + 128 + (2 * s2 + 1) * 16 + 8 * h);
                m2 = __builtin_amdgcn_mfma_f32_32x32x16_bf16(__builtin_shufflevector(lo, hi, 0, 1, 2, 3, 4, 5, 6, 7), __builtin_bit_cast(bf16x8, w), m2, 0, 0, 0); }
            const float be = sm[64 + r], beg = be * __expf(sm[r]);
#pragma unroll
            for (int i = 0; i < 16; ++i) { const int row = 32 + (i & 3) + 8 * (i >> 2) + 4 * h;
                *(LAS bf16_t*)(TT + row * 272 + r * 2) = (bf16_t)f2bf(-m2[i] * be); *(LAS bf16_t*)(TT + row * 272 + 128 + r * 2) = (bf16_t)f2bf(-m2[i] * beg); }
        }
        __syncthreads();
        { f32x16 u[2];
#pragma unroll
            for (int ib = 0; ib < 2; ++ib)
#pragma unroll
                for (int i = 0; i < 16; ++i) u[ib][i] = 0.f;
#pragma unroll
            for (int s = 0; s < 4; ++s) { const int ch = 4 * gw + 2 * blk + (p >> 1);
                const s16x4 lo = tr_read(VT + ppos(16 * s + 8 * h + q, ch) + (p & 1) * 8), hi = tr_read(VT + ppos(16 * s + 8 * h + 4 + q, ch) + (p & 1) * 8);
                const bf16x8 bv = __builtin_shufflevector(lo, hi, 0, 1, 2, 3, 4, 5, 6, 7);
#pragma unroll
                for (int ib = 0; ib < 2; ++ib) { if (ib == 0 && s >= 2) continue; const bf16x8 a = *(const LAS bf16x8*)(TT + ppos(ib * 32 + r, 2 * s + h)); u[ib] = __builtin_amdgcn_mfma_f32_32x32x16_bf16(a, bv, u[ib], 0, 0, 0); } }
            if (valid) {
#pragma unroll
                for (int ib = 0; ib < 2; ++ib)
#pragma unroll
                    for (int g = 0; g < 4; ++g) { u32x2 w; w.x = pk2(u[ib][4 * g], u[ib][4 * g + 1]); w.y = pk2(u[ib][4 * g + 2], u[ib][4 * g + 3]); *(u32x2*)(UT + (size_t)(gw * 32 + r) * 64 + ib * 32 + 8 * g + 4 * h) = w; } } }
        { const int db = gw & 1, ib = gw >> 1; f32x16 w;
#pragma unroll
            for (int i = 0; i < 16; ++i) w[i] = 0.f;
#pragma unroll
            for (int s = 0; s < 4; ++s) { if (ib == 0 && s >= 2) continue; const int ch = 4 * db + 2 * blk + (p >> 1);
                const s16x4 lo = tr_read(KQ + ppos(16 * s + 8 * h + q, ch) + (p & 1) * 8), hi = tr_read(KQ + ppos(16 * s + 8 * h + 4 + q, ch) + (p & 1) * 8);
                const bf16x8 a = __builtin_shufflevector(lo, hi, 0, 1, 2, 3, 4, 5, 6, 7);
                const bf16x8 bt = *(const LAS bf16x8*)(TT + ppos(ib * 32 + r, 8 + 2 * s + h)); w = __builtin_amdgcn_mfma_f32_32x32x16_bf16(a, bt, w, 0, 0, 0); }
            if (valid) {
#pragma unroll
                for (int g = 0; g < 4; ++g) { const int d0 = db * 32 + 8 * g + 4 * h; u32x2 o; o.x = pk2(-w[4 * g], -w[4 * g + 1]); o.y = pk2(-w[4 * g + 2], -w[4 * g + 3]);
                    *(u32x2*)(img + tpos(ib * 32 + r, d0 >> 3) + (d0 & 7) * 2) = o; } } }
        __syncthreads();
    } else { __syncthreads(); __syncthreads(); __syncthreads(); }
}
DI void phase_seqprep(const Ctx& F, int l) {
    const int grp = F.wave >> 2, N = 2 * NBATCH * 4 * NCHUNK;
    LAS unsigned char* gl = F.lds + grp * 69632; LAS float* sm = (LAS float*)(F.lds + 139264 + grp * 512);
    const int iters = (N + F.G - 1) / F.G;
    for (int k = 0; k < iters; ++k) { int it = k * F.G + F.bid; const bool valid = it < N; if (!valid) it = N - 1; prep_chunk(F, l, it, valid, gl, sm); }
}
DI void seq_chunked_item(const Ctx& F, int l, int item, unsigned done_off) {
    const int lane = F.lane, grp = F.wave >> 2, eb = F.wave & 3, gt = F.tid & 255, r = lane & 31, h = lane >> 5, q = (lane & 15) >> 2, p = lane & 3, blk = (lane >> 4) & 1;
    const int seq = item * 2 + grp, dir = seq & 1, hd = (seq >> 1) & 3, b = (seq >> 3) & 7, br = seq >> 6;
    const unsigned char* TG = F.ws + WS_SEQT + (size_t)seq * NCHUNK * 32768; const bf16_t* UG = (const bf16_t*)(F.ws + WS_SEQU + (size_t)seq * NCHUNK * 16384) + (size_t)(eb * 32 + r) * 64 + 4 * h;
    const float* GL = WSP(float, WS_SEQG) + (size_t)seq * NCHUNK;
    LAS unsigned char* gb = F.lds + grp * 65536;
    int aW[4][2], aQ[4][2], aK[2][2];
#pragma unroll
    for (int s = 0; s < 4; ++s)
#pragma unroll
        for (int hi = 0; hi < 2; ++hi) { aW[s][hi] = tpos(r, 2 * s + hi) + 8 * h; aQ[s][hi] = tpos(r, 8 + 2 * s + hi) + 8 * h; }
#pragma unroll
    for (int hi = 0; hi < 2; ++hi)
#pragma unroll
        for (int db = 0; db < 2; ++db) aK[hi][db] = tpos(8 * hi + 4 * h + q, 8 + 4 * db + 2 * blk + (p >> 1)) + (p & 1) * 8;
    auto stage = [&](int c) {
#pragma unroll
        for (int i = 0; i < 8; ++i) glds16(TG + (size_t)c * 32768 + (size_t)(gt + 256 * i) * 16, gb + (c & 1) * 32768 + (eb * 64 + 256 * i) * 16); };
    u32x2 ur[2][4];
    auto loadu = [&](int c) {
#pragma unroll
        for (int ib = 0; ib < 2; ++ib)
#pragma unroll
            for (int g = 0; g < 4; ++g) ur[ib][g] = *(const u32x2*)(UG + (size_t)c * 8192 + ib * 32 + 8 * g); };
    f32x16 S[2];
#pragma unroll
    for (int db = 0; db < 2; ++db)
#pragma unroll
        for (int i = 0; i < 16; ++i) S[db][i] = 0.f;
    bf16_t* oseq = WSP(bf16_t, WS_OSEQ) + ((size_t)(br * 2 + dir) * T) * 512 + hd * 128 + eb * 32 + r;
    stage(0); loadu(0);
    for (int c = 0; c < NCHUNK; ++c) {
        asm volatile("s_waitcnt vmcnt(0)" ::: "memory"); __syncthreads();
        if (c + 1 < NCHUNK) stage(c + 1);
        const LAS unsigned char* t1 = gb + (c & 1) * 32768; const LAS unsigned char* t2 = t1 + 16384;
        f32x16 V2[2], O[2];
#pragma unroll
        for (int ib = 0; ib < 2; ++ib)
#pragma unroll
            for (int g = 0; g < 4; ++g) { V2[ib][4 * g] = __uint_as_float(ur[ib][g].x << 16); V2[ib][4 * g + 1] = __uint_as_float(ur[ib][g].x & 0xffff0000u); V2[ib][4 * g + 2] = __uint_as_float(ur[ib][g].y << 16); V2[ib][4 * g + 3] = __uint_as_float(ur[ib][g].y & 0xffff0000u); }
        if (c + 1 < NCHUNK) loadu(c + 1);
        const float gl = GL[c];
        bf16x8 sb[4];
#pragma unroll
        for (int s = 0; s < 4; ++s) { const int db = s >> 1, o = 8 * (s & 1); u32x4 w; w.x = cvt_pk_bf16(S[db][o], S[db][o + 1]); w.y = cvt_pk_bf16(S[db][o + 2], S[db][o + 3]); w.z = cvt_pk_bf16(S[db][o + 4], S[db][o + 5]); w.w = cvt_pk_bf16(S[db][o + 6], S[db][o + 7]); sb[s] = __builtin_bit_cast(bf16x8, w); }
#pragma unroll
        for (int ib = 0; ib < 2; ++ib) {
#pragma unroll
            for (int i = 0; i < 16; ++i) O[ib][i] = 0.f;
#pragma unroll
            for (int s = 0; s < 4; ++s) {
                if (br == 1) { const s16x4 lo = *(const LAS s16x4*)(t1 + aW[s][0] + ib * 8192), hi = *(const LAS s16x4*)(t1 + aW[s][1] + ib * 8192);
                    V2[ib] = __builtin_amdgcn_mfma_f32_32x32x16_bf16(__builtin_shufflevector(lo, hi, 0, 1, 2, 3, 4, 5, 6, 7), sb[s], V2[ib], 0, 0, 0); }
                const s16x4 lo = *(const LAS s16x4*)(t1 + aQ[s][0] + ib * 8192), hi = *(const LAS s16x4*)(t1 + aQ[s][1] + ib * 8192);
                O[ib] = __builtin_amdgcn_mfma_f32_32x32x16_bf16(__builtin_shufflevector(lo, hi, 0, 1, 2, 3, 4, 5, 6, 7), sb[s], O[ib], 0, 0, 0); } }
        bf16x8 vb[4];
#pragma unroll
        for (int s = 0; s < 4; ++s) { const int jb = s >> 1, o = 8 * (s & 1); u32x4 w; w.x = cvt_pk_bf16(V2[jb][o], V2[jb][o + 1]); w.y = cvt_pk_bf16(V2[jb][o + 2], V2[jb][o + 3]); w.z = cvt_pk_bf16(V2[jb][o + 4], V2[jb][o + 5]); w.w = cvt_pk_bf16(V2[jb][o + 6], V2[jb][o + 7]); vb[s] = __builtin_bit_cast(bf16x8, w); }
#pragma unroll
        for (int ib = 0; ib < 2; ++ib)
#pragma unroll
            for (int s = 0; s < 4; ++s) { if (ib == 0 && s >= 2) continue;
                const s16x4 lo = *(const LAS s16x4*)(t2 + aW[s][0] + ib * 8192), hi = *(const LAS s16x4*)(t2 + aW[s][1] + ib * 8192);
                O[ib] = __builtin_amdgcn_mfma_f32_32x32x16_bf16(__builtin_shufflevector(lo, hi, 0, 1, 2, 3, 4, 5, 6, 7), vb[s], O[ib], 0, 0, 0); }
#pragma unroll
        for (int db = 0; db < 2; ++db) {
#pragma unroll
            for (int i = 0; i < 16; ++i) S[db][i] *= gl;
#pragma unroll
            for (int s = 0; s < 4; ++s) { const s16x4 lo = tr_read(t2 + aK[0][db] + s * 4096), hi = tr_read(t2 + aK[1][db] + s * 4096);
                S[db] = __builtin_amdgcn_mfma_f32_32x32x16_bf16(__builtin_shufflevector(lo, hi, 0, 1, 2, 3, 4, 5, 6, 7), vb[s], S[db], 0, 0, 0); } }
#pragma unroll
        for (int ib = 0; ib < 2; ++ib)
#pragma unroll
            for (int i = 0; i < 16; ++i) { const int row = ib * 32 + (i & 3) + 8 * (i >> 2) + 4 * h; const int m = b * LTOK + scan_pos(c * 64 + row, dir); oseq[(size_t)m * 512] = (bf16_t)f2bf(O[ib][i]); }
    }
    asm volatile("s_waitcnt vmcnt(0)" ::: "memory");
    __syncthreads();
    if (F.tid == 0) { __builtin_amdgcn_fence(__ATOMIC_RELEASE, "agent"); asm volatile("s_waitcnt vmcnt(0)" ::: "memory"); { unsigned o_ = done_off; asm volatile("" : "+s"(o_)); __hip_atomic_fetch_add((int*)(F.ws + o_), 1, __ATOMIC_RELAXED, __HIP_MEMORY_SCOPE_AGENT); } }
    __syncthreads();
}
DI void seqpost_rows(const Ctx& F, int l, int m_lo) {
    const int lane = F.lane;
    const bf16_t* os = WSP(bf16_t, WS_OSEQ);
    for (int m = m_lo + F.wave * 8; m < m_lo + F.wave * 8 + 8; ++m) {
        const bf16_t* prow = WSP(bf16_t, WS_P) + (size_t)m * PW;
#pragma unroll
        for (int br = 0; br < 2; ++br) {
            const bf16_t* o0 = os + ((size_t)(br * 2 + 0) * T + m) * 512 + lane * 8; const bf16_t* o1 = os + ((size_t)(br * 2 + 1) * T + m) * 512 + lane * 8;
            float f[8];
            { float fa[8], fb[8]; unpack8(*(const u32x4*)o0, fa); unpack8(*(const u32x4*)o1, fb);
#pragma unroll
                for (int i = 0; i < 8; ++i) f[i] = fa[i] + fb[i]; }
            float s1 = 0.f;
            if (br == 0) {
#pragma unroll
                for (int i = 0; i < 8; ++i) s1 += f[i];
                s1 += xshfl<1>(s1); s1 += xshfl<2>(s1); s1 += xshfl<4>(s1); s1 += xshfl<8>(s1);
                const float mean = s1 * (1.f / 128.f);
#pragma unroll
                for (int i = 0; i < 8; ++i) f[i] -= mean; }
            float ss = 0.f;
#pragma unroll
            for (int i = 0; i < 8; ++i) ss += f[i] * f[i];
            ss += xshfl<1>(ss); ss += xshfl<2>(ss); ss += xshfl<4>(ss); ss += xshfl<8>(ss);
            const float r = rsqrtf(ss * (1.f / 128.f) + EPS);
            const float* gn = (br == 0 ? GIN(F.in, I_RETGN) : GIN(F.in, I_DNNORM)) + (size_t)l * 128 + (lane & 15) * 8;
            float g[8]; unpack8(*(const u32x4*)(prow + (br == 0 ? C_RG : C_DNG) + lane * 8), g);
#pragma unroll
            for (int i = 0; i < 8; ++i) f[i] = f[i] * r * gn[i] * siluf_(g[i]);
            *(u32x4*)(WSP(bf16_t, WS_YS) + (size_t)m * YSW + (br == 0 ? 512 : 1536) + lane * 8) = pack8(f);
        }
    }
}
DI void phase_mixers(const Ctx& F, int l, int rep = 0) {
    const bool last = (l == DEPTH - 1);
    const int N_SEQ = NSEQ / 2, N_DIFF_L = NBATCH * 4 * 16, N_DIFF_C = last ? 0 : NBATCH * 4 * 2, N_NA_L = NBATCH * 8 * 8, N_NA_C = last ? 0 : NBATCH * 8;
#ifndef MIXMASK
#define MIXMASK 7
#endif
    const unsigned ctr_off = (unsigned)(WS_BAR + 14400) + (l * 4 + rep * 8) * 4, done_off = (unsigned)(WS_BAR + 14400) + (16 + l + rep * 2) * 4;
    volatile LAS int* slot = (volatile LAS int*)(F.lds + LDS_BYTES - 32);
#define NEXT_ITEM(q, var) { __syncthreads(); if (F.tid == 0) { unsigned o_ = ctr_off + 4 * (q); asm volatile("" : "+s"(o_)); slot[0] = atomicAdd((int*)(F.ws + o_), 1); } __syncthreads(); var = slot[0]; }
    if (F.wave >= 4) __builtin_amdgcn_s_setprio(1);
    const int NCD = l == 0 ? (CV_NITEM * 2) / 3 : 0, NCN = l == 0 ? CV_NITEM - NCD : 0, NDT = N_DIFF_L + N_DIFF_C + NCD, NNT = N_NA_L + N_NA_C + NCN;
    int it;
    for (;;) { NEXT_ITEM(0, it) if (it >= N_SEQ) break; if (MIXMASK & 1) seq_chunked_item(F, l, it, done_off); }
    for (;;) { NEXT_ITEM(1, it) if (it >= NDT) break;
        const int c0 = (int)(((long)it * NCD) / NDT), c1 = (int)(((long)(it + 1) * NCD) / NDT);
        if (c1 > c0) { convert_range(F, CV_N0, c0 * CV_ITEM, c0 * CV_ITEM + CV_ITEM, 1, 0); continue; }
        if (MIXMASK & 2) { const int ia = it - c0; const bool cq = ia >= N_DIFF_L; const int j = cq ? ia - N_DIFF_L : ia;
            diff_item(F, l, cq ? j >> 3 : j >> 6, cq ? (j >> 1) & 3 : (j >> 4) & 3, cq ? (j & 1) * 128 : CTX + (j & 15) * 128, cq ? CTX : LTOK); } }
    for (;;) { NEXT_ITEM(2, it) if (it >= NNT) break;
        const int c0 = (int)(((long)it * NCN) / NNT), c1 = (int)(((long)(it + 1) * NCN) / NNT);
        if (c1 > c0) { convert_range(F, CV_N0, (NCD + c0) * CV_ITEM, (NCD + c0) * CV_ITEM + CV_ITEM, 1, 0); continue; }
        if (MIXMASK & 4) { const int ia = it - c0; const bool cq = ia >= N_NA_L; const int j = cq ? ia - N_NA_L : ia; na_item(F, l, cq ? j >> 3 : j >> 6, cq ? j & 7 : (j >> 3) & 7, cq ? 0 : j & 7, cq); } }
    if (F.tid == 0) { unsigned sp = 0; unsigned o_ = done_off; asm volatile("" : "+s"(o_)); const int* done = (const int*)(F.ws + o_); while (__hip_atomic_load(done, __ATOMIC_RELAXED, __HIP_MEMORY_SCOPE_AGENT) < N_SEQ) { __builtin_amdgcn_s_sleep(4); if (++sp > (1u << 22)) break; }
        __builtin_amdgcn_fence(__ATOMIC_ACQUIRE, "agent"); asm volatile("s_waitcnt vmcnt(0)" ::: "memory"); }
    for (;;) { NEXT_ITEM(3, it) if (it >= T / 64) break; seqpost_rows(F, l, it * 64); }
    __builtin_amdgcn_s_setprio(0);
#undef NEXT_ITEM
}
DI void phase_sum4(const Ctx& F, int l) {
    const unsigned char* G = F.ws + WS_P; bf16_t* mx = WSP(bf16_t, WS_MIXED);
    const int nrows = l == DEPTH - 1 ? NBATCH * SEQ : T;
    for (int i = F.bid * 512 + F.tid; i < nrows * 64; i += F.G * 512) { int row = i >> 6; const int c16 = (i & 63) * 16; if (l == DEPTH - 1) row = (row / SEQ) * LTOK + CTX + row % SEQ;
        float a[16];
#pragma unroll
        for (int j = 0; j < 16; ++j) a[j] = 0.f;
        u32x4 w[4];
#pragma unroll
        for (int n = 0; n < 4; ++n) w[n] = *(const u32x4*)(G + (size_t)row * 4096 + n * D + c16);
#pragma unroll
        for (int n = 0; n < 4; ++n)
#pragma unroll
            for (int k = 0; k < 4; ++k) { const f32x2 lo = __builtin_amdgcn_cvt_pk_f32_fp8((int)w[n][k], false), hi = __builtin_amdgcn_cvt_pk_f32_fp8((int)w[n][k], true);
                a[4 * k] += lo[0]; a[4 * k + 1] += lo[1]; a[4 * k + 2] += hi[0]; a[4 * k + 3] += hi[1]; }
        u32x4 o0, o1; constexpr float r = 1.f / G8S;
        o0.x = pk2(a[0] * r, a[1] * r); o0.y = pk2(a[2] * r, a[3] * r); o0.z = pk2(a[4] * r, a[5] * r); o0.w = pk2(a[6] * r, a[7] * r);
        o1.x = pk2(a[8] * r, a[9] * r); o1.y = pk2(a[10] * r, a[11] * r); o1.z = pk2(a[12] * r, a[13] * r); o1.w = pk2(a[14] * r, a[15] * r);
        *(u32x4*)(mx + (size_t)row * D + c16) = o0; *(u32x4*)(mx + (size_t)row * D + c16 + 8) = o1; }
}
DI void split4(const f32x4 v, u32x2& hi, u32x2& lo) {
    hi.x = cvt_pk_bf16(v[0], v[1]); hi.y = cvt_pk_bf16(v[2], v[3]);
    lo.x = cvt_pk_bf16(v[0] - __uint_as_float(hi.x << 16), v[1] - __uint_as_float(hi.x & 0xffff0000u));
    lo.y = cvt_pk_bf16(v[2] - __uint_as_float(hi.y << 16), v[3] - __uint_as_float(hi.y & 0xffff0000u));
}
DI void phase_route(const Ctx& F, int l) {
    constexpr int TT = 24, XROW = 2064, XLO = TT * XROW, POFF = 2 * TT * XROW;
    const int lane = F.lane, wave = F.wave; const bool last = l == DEPTH - 1;
    const float* mod = WSP(float, WS_MOD) + (size_t)l * 9 * 6144;
    const float* gain = GIN(F.in, I_NFFN) + (size_t)l * D;
    int* cnt = WSP(int, WS_CNT) + l * NE; int* amap = WSP(int, WS_AMAP) + (size_t)l * NE * AMAX; float* gateb = WSP(float, WS_GATEB) + (size_t)l * A_TOT;
    LAS int* lcnt = (LAS int*)(F.lds + LDS_MISC); LAS int* lbase = lcnt + 32; LAS int* lst = lcnt + 64;
    constexpr int MAXTOK = 42;
    if (F.tid < 32) lcnt[F.tid] = 0;
    for (int i = F.tid; i < 8 * MAXTOK * 4; i += 512) lst[2 * i + 1] = -1;
    bf16x8 Wh[8], Wl[8];
    { const float* wr = WSP(float, WS_RWT) + (size_t)l * NE * D + (size_t)(lane & 31) * D + 128 * wave + 8 * (lane >> 5);
#pragma unroll
        for (int s = 0; s < 8; ++s) { const f32x4 a = *(const f32x4*)(wr + 16 * s), b = *(const f32x4*)(wr + 16 * s + 4); u32x2 ha, la, hb, lb; split4(a, ha, la); split4(b, hb, lb);
            u32x4 h4; h4.x = ha.x; h4.y = ha.y; h4.z = hb.x; h4.w = hb.y; u32x4 l4; l4.x = la.x; l4.y = la.y; l4.z = lb.x; l4.w = lb.y;
            Wh[s] = __builtin_bit_cast(bf16x8, h4); Wl[s] = __builtin_bit_cast(bf16x8, l4); } }
    const int skip = last ? 240 : 0, per_b = (LTOK - skip) / TT, ntile = NBATCH * per_b;
    u32x2 nx[3][4];
    if (F.bid < ntile) { const int b = F.bid / per_b; const int m0 = b * LTOK + skip + (F.bid - b * per_b) * TT + 3 * wave;
#pragma unroll
        for (int t = 0; t < 3; ++t)
#pragma unroll
            for (int j = 0; j < 4; ++j) nx[t][j] = *(const u32x2*)(WSP(bf16_t, WS_XRES) + (size_t)(m0 + t) * D + 4 * lane + 256 * j); }
    __syncthreads();
    const int myexp = 8 * (lane & 3) + 4 * ((lane >> 4) & 1) + 2 * ((lane >> 3) & 1) + ((lane >> 2) & 1);
    const float mybias = GIN(F.in, I_RB)[l * NE + myexp];
    int tk = 0, mr_c = -1; f32x4 cA[4], cB[4];
#pragma unroll
    for (int j = 0; j < 4; ++j) { cA[j] = (f32x4){0.f, 0.f, 0.f, 0.f}; cB[j] = cA[j]; }
    for (int jt = F.bid; jt < ntile; jt += F.G, tk += 3) {
        int jl = jt; asm volatile("" : "+v"(jl)); jl = __builtin_amdgcn_readfirstlane(jl);
        const int bb = jl / per_b; const int m0 = bb * LTOK + skip + (jl - bb * per_b) * TT + 3 * wave;
        bool live[3];
#pragma unroll
        for (int t = 0; t < 3; ++t) { const int m = m0 + t, pos = m - bb * LTOK, mr = pos < CTX ? 8 : bb;
            live[t] = !(last && pos < CTX);
            float ss = 0.f; f32x4 xv[4];
#pragma unroll
            for (int j = 0; j < 4; ++j) { xv[j] = unpack4(nx[t][j]); ss += xv[j][0] * xv[j][0] + xv[j][1] * xv[j][1] + xv[j][2] * xv[j][2] + xv[j][3] * xv[j][3]; }
            const float rstd = rsqrtf(wave_sum(ss) * (1.f / D) + EPS);
            unsigned char* o = F.ws + WS_HZ + (size_t)m * D;
            LAS unsigned char* xr = F.lds + (3 * wave + t) * XROW + 8 * lane;
            if (mr != mr_c) { mr_c = mr;
#pragma unroll
                for (int j = 0; j < 4; ++j) { const int col = 4 * lane + 256 * j; cA[j] = *(const f32x4*)(gain + col) * (*(const f32x4*)(mod + (size_t)mr * 6144 + 4 * D + col) + 1.f); cB[j] = *(const f32x4*)(mod + (size_t)mr * 6144 + 3 * D + col); } }
#pragma unroll
            for (int j = 0; j < 4; ++j) { const int col = 4 * lane + 256 * j;
                const f32x4 v = xv[j] * rstd * cA[j] + cB[j]; if (live[t]) *(unsigned*)(o + col) = pk4_fp8(v[0], v[1], v[2], v[3]);
                u32x2 hi, lo; split4(v, hi, lo); *(LAS u32x2*)(xr + 512 * j) = hi; *(LAS u32x2*)(xr + XLO + 512 * j) = lo; } }
        { const int jn = jl + F.G;
            if (jn < ntile) { const int b2 = jn / per_b; const int m2 = b2 * LTOK + skip + (jn - b2 * per_b) * TT + 3 * wave;
#pragma unroll
                for (int t = 0; t < 3; ++t)
#pragma unroll
                    for (int j = 0; j < 4; ++j) nx[t][j] = *(const u32x2*)(WSP(bf16_t, WS_XRES) + (size_t)(m2 + t) * D + 4 * lane + 256 * j); } }
        __syncthreads();
        f32x16 acc, acc1, acc2;
#pragma unroll
        for (int i = 0; i < 16; ++i) { acc[i] = 0.f; acc1[i] = 0.f; acc2[i] = 0.f; }
        { const int tn = (lane & 31) < TT ? (lane & 31) : TT - 1;
            const LAS unsigned char* xb = F.lds + tn * XROW + 256 * wave + 16 * (lane >> 5);
#pragma unroll
            for (int s = 0; s < 8; ++s) { const bf16x8 bh = *(const LAS bf16x8*)(xb + 32 * s), bl = *(const LAS bf16x8*)(xb + XLO + 32 * s);
                acc = __builtin_amdgcn_mfma_f32_32x32x16_bf16(Wh[s], bh, acc, 0, 0, 0); acc1 = __builtin_amdgcn_mfma_f32_32x32x16_bf16(Wh[s], bl, acc1, 0, 0, 0); acc2 = __builtin_amdgcn_mfma_f32_32x32x16_bf16(Wl[s], bh, acc2, 0, 0, 0); }
#pragma unroll
            for (int i = 0; i < 16; ++i) acc[i] += acc1[i] + acc2[i]; }
        if ((lane & 31) < TT) { LAS float* pp = (LAS float*)(F.lds + POFF) + wave * (NE * TT) + (lane & 31);
#pragma unroll
            for (int i = 0; i < 16; ++i) pp[((i & 3) + 8 * (i >> 2) + 4 * (lane >> 5)) * TT] = acc[i]; }
        __syncthreads();
#pragma unroll
        for (int t = 0; t < 3; ++t) {
            const LAS float* pr = (const LAS float*)(F.lds + POFF) + myexp * TT + 3 * wave + t;
            float mv = pr[0];
#pragma unroll
            for (int w = 1; w < 8; ++w) mv += pr[w * (NE * TT)];
            mv += mybias;
            const unsigned u0 = __float_as_uint(mv); unsigned key = ((u0 ^ ((unsigned)((int)u0 >> 31) | 0x80000000u)) & ~31u) | (unsigned)(31 - myexp);
            int ti[4]; float tv[4];
#pragma unroll
            for (int k = 0; k < 4; ++k) { unsigned km = key;
                km = max(km, (unsigned)__builtin_amdgcn_update_dpp(km, km, 0xB1, 0xF, 0xF, false)); km = max(km, (unsigned)__builtin_amdgcn_update_dpp(km, km, 0x4E, 0xF, 0xF, false));
                km = max(km, (unsigned)__builtin_amdgcn_update_dpp(km, km, 0x141, 0xF, 0xF, false)); km = max(km, (unsigned)__builtin_amdgcn_update_dpp(km, km, 0x140, 0xF, 0xF, false));
                { const auto r2 = __builtin_amdgcn_permlane16_swap(km, km, false, false); km = max((unsigned)r2[0], (unsigned)r2[1]); }
                ti[k] = 31 - (int)(km & 31u); const unsigned o2 = km & ~31u; tv[k] = __uint_as_float((o2 & 0x80000000u) ? (o2 ^ 0x80000000u) : ~o2); if (myexp == ti[k]) key = 0u; }
            const float e0 = 1.f, e1 = __expf(tv[1] - tv[0]), e2 = __expf(tv[2] - tv[0]), e3 = __expf(tv[3] - tv[0]); const float inv = 1.f / (e0 + e1 + e2 + e3);
            if (lane < 4 && live[t]) { const int m = m0 + t; const int ek = lane == 0 ? ti[0] : lane == 1 ? ti[1] : lane == 2 ? ti[2] : ti[3]; const float gk = (lane == 0 ? e0 : lane == 1 ? e1 : lane == 2 ? e2 : e3) * inv;
                const int lp = __hip_atomic_fetch_add(lcnt + ek, 1, __ATOMIC_RELAXED, __HIP_MEMORY_SCOPE_WORKGROUP);
                const int idx = (wave * MAXTOK + tk + t) * 4 + lane; lst[2 * idx] = ek | (lp << 8); lst[2 * idx + 1] = m * 4 + lane; gateb[(size_t)m * 4 + lane] = gk; }
        }
    }
    __syncthreads();
    if (F.tid < 32) { const int c = lcnt[F.tid]; lbase[F.tid] = c > 0 ? atomicAdd(cnt + F.tid, c) : 0; }
    __syncthreads();
    for (int i = F.tid; i < 8 * MAXTOK * 4; i += 512) { const int a = lst[2 * i + 1]; if (a >= 0) { const int w = lst[2 * i], ek = w & 255, lp = w >> 8; amap[(size_t)ek * AMAX + lbase[ek] + lp] = a; } }
    __syncthreads();
}
DI void moe_prefix(const Ctx& F, int l) {
    LAS int* pref = (LAS int*)(F.lds + LDS_MISC);
    if (F.tid == 0) { const int* cnt = WSP(int, WS_CNT) + l * NE; int s = 0;
#pragma unroll 1
        for (int e = 0; e < NE; ++e) { pref[e] = s; s += (__hip_atomic_load(cnt + e, __ATOMIC_RELAXED, __HIP_MEMORY_SCOPE_AGENT) + 255) >> 8; } pref[NE] = s; }
    __syncthreads();
}
DI void phase_final(const Ctx& F) {
    const int gw = F.bid * 8 + F.wave, NGW = F.G * 8;
    for (int q = gw; q < NBATCH * SEQ; q += NGW) {
        const int b = q / SEQ, i = q - b * SEQ, m = b * LTOK + CTX + i;
        f32x4 cv[4]; moe_comb_row(F, 1, m, cv);
        const bf16_t* xr = WSP(bf16_t, WS_XRES) + (size_t)m * D; const float* m5 = WSP(float, WS_MOD) + ((size_t)9 + b) * 6144 + 5 * D;
#pragma unroll
        for (int j = 0; j < 4; ++j) { const int col = 4 * F.lane + 256 * j; *(f32x4*)(F.out + (size_t)q * D + col) = unpack4(*(const u32x2*)(xr + col)) + *(const f32x4*)(m5 + col) * cv[j]; }
    }
}

#define XB_TMO      128
#define XB_XCNT(j)  (256  + 64 * (j))
#define XB_XSUB(j)  (1280 + 64 * (j))
#define XB_XGEN(j)  (2304 + 64 * (j))
#define XB_TOP      3328
#define XB_TOPGEN   3392
#define XCD_BAR_WORDS 3456
#define XB_SPIN_CAP (1u << 18)
DI unsigned xb_ld(unsigned* p) { return __hip_atomic_load(p, __ATOMIC_RELAXED, __HIP_MEMORY_SCOPE_AGENT); }
DI unsigned xb_add(unsigned* p, unsigned v) { return __hip_atomic_fetch_add(p, v, __ATOMIC_RELAXED, __HIP_MEMORY_SCOPE_AGENT); }
DI unsigned xb_xcc_id() { return (unsigned)__builtin_amdgcn_s_getreg((3 << 11) | 20) & 0xFu; }
#define XB_SPIN(cond, bar) do { unsigned _sp = 0; while (cond) { __builtin_amdgcn_s_sleep(1); \
    if ((++_sp & 255u) == 0u) { if (xb_ld(&(bar)[XB_TMO])) break; if (_sp > XB_SPIN_CAP) { atomicAdd(&(bar)[XB_TMO], 1u); break; } } } } while (0)
struct XcdBarrier { unsigned* bar; unsigned x; volatile LAS unsigned* st; int wid; };
DI XcdBarrier xcd_barrier_post(unsigned* bar, volatile LAS unsigned* st) {
    XcdBarrier b; b.bar = bar; b.x = xb_xcc_id(); b.st = st; b.wid = __builtin_amdgcn_readfirstlane((int)threadIdx.x >> 6);
    if (threadIdx.x == 0) (void)xb_add(&bar[XB_XCNT(b.x)], 1u);
    return b;
}
DI void xcd_barrier_complete(unsigned* bar, unsigned x, unsigned& nloc, unsigned& nx) {
    const unsigned G = gridDim.x * gridDim.y * gridDim.z;
    unsigned sum, cnt, mine, sp = 0u;
    for (;;) {
        sum = 0u; cnt = 0u; mine = 0u;
#pragma unroll
        for (unsigned j = 0; j < 16; ++j) { const unsigned c = xb_ld(&bar[XB_XCNT(j)]); sum += c; cnt += (c > 0u) ? 1u : 0u; mine = (j == x) ? c : mine; }
        if (sum == G) break;
        __builtin_amdgcn_s_sleep(1);
        if ((++sp & 255u) == 0u) { if (xb_ld(&bar[XB_TMO])) break; if (sp > XB_SPIN_CAP) { atomicAdd(&bar[XB_TMO], 1u); break; } }
    }
    nloc = mine > 0u ? mine : 1u; nx = cnt > 0u ? cnt : 1u;
}
DI void xcd_barrier(const XcdBarrier& b) {
    asm volatile("s_waitcnt vmcnt(0)" ::: "memory");
    __syncthreads();
    if (b.wid == 0 && hw_lane() == 0u) {
        unsigned* bar = b.bar;
        __builtin_amdgcn_s_waitcnt(0);
        unsigned nloc = b.st[0], nx = b.st[1];
        if (nloc == 0u) { xcd_barrier_complete(bar, b.x, nloc, nx); b.st[0] = nloc; b.st[1] = nx; }
        const unsigned old = xb_add(&bar[XB_XSUB(b.x)], 1u);
        const unsigned gen = old / nloc;
        if (old + 1u == (gen + 1u) * nloc) {
            __builtin_amdgcn_fence(__ATOMIC_RELEASE, "agent");
            asm volatile("s_waitcnt vmcnt(0)" ::: "memory");
            const unsigned og = xb_add(&bar[XB_TOP], 1u);
            const unsigned tg = og / nx;
            if (og + 1u == (tg + 1u) * nx) xb_add(&bar[XB_TOPGEN], 1u);
            else XB_SPIN(xb_ld(&bar[XB_TOPGEN]) == tg, bar);
            __builtin_amdgcn_fence(__ATOMIC_ACQUIRE, "agent");
            xb_add(&bar[XB_XGEN(b.x)], 1u);
            asm volatile("s_waitcnt vmcnt(0)" ::: "memory");
        } else {
            XB_SPIN(xb_ld(&bar[XB_XGEN(b.x)]) == gen, bar);
            __builtin_amdgcn_fence(__ATOMIC_ACQUIRE, "agent");
            asm volatile("s_waitcnt vmcnt(0)" ::: "memory");
        }
    }
    __syncthreads();
}
constexpr int NSUB = 10;
constexpr int N_PHASES = 1 + NSUB * DEPTH + 1;
#ifndef PHMASK
#define PHMASK 0xFFFFF
#endif
#define PHE(x) ((PHMASK >> (x)) & 1)
#ifndef REPMASK
#define REPMASK 0
#endif
#define NREP(x) (1 + ((REPMASK >> (x)) & 1))
#define PH_LAUNDER { const __attribute__((address_space(4))) cfp_t* pin_ = (const __attribute__((address_space(4))) cfp_t*)__builtin_amdgcn_kernarg_segment_ptr(); __attribute__((address_space(1))) unsigned char* pws_ = (__attribute__((address_space(1))) unsigned char*)P.ws; __attribute__((address_space(1))) float* pout_ = (__attribute__((address_space(1))) float*)P.out; int w_ = xb.wid, l_, g_ = P.G, b_ = blockIdx.x; unsigned lb_ = 0; \
      asm volatile("v_mbcnt_lo_u32_b32 %0, -1, 0\n\tv_mbcnt_hi_u32_b32 %0, -1, %0" : "=v"(l_)); \
      asm volatile("" : "+s"(pin_), "+s"(pws_), "+s"(pout_), "+s"(w_), "+s"(g_), "+s"(b_), "+s"(lb_)); const int t_ = (w_ << 6) | l_; \
      F.in = pin_; F.ws = (unsigned char*)pws_; F.out = (float*)pout_; F.tid = t_; F.lane = t_ & 63; F.wave = w_; F.G = g_; F.bid = b_; F.lds = (LAS unsigned char*)lds_raw + lb_; }
#define RUN_PHASE(k, bit, ...) if (P.ph_lo <= (k) && (k) < P.ph_hi) { if ((k) > P.ph_lo) xcd_barrier(xb); PH_LAUNDER if (PHE(bit)) { const int rep_ = 0; (void)rep_; __VA_ARGS__ } if (NREP(bit) > 1) { const int rep_ = 1; (void)rep_; __syncthreads(); PH_LAUNDER __VA_ARGS__ } }
template <int l> DI void run_layer(const Params& P, Ctx& F, const XcdBarrier& xb, unsigned char* lds_raw) {
    constexpr int base = 1 + NSUB * l;
    RUN_PHASE(base + 0, 0, phase_norm(F, l);)
    RUN_PHASE(base + 1, 1,
        _Pragma("unroll 1") for (int half = 0; half < 2; ++half) { PH_LAUNDER
          pg8::DenseSched S; S.init(T, 6144, D, D, WSP(bf16_t, WS_W1T) + (size_t)l * NG1 * D, F.G, F.bid); S.i0 = half * 3; S.i1 = half == 0 ? 3 : (1 << 30);
          pg8::EpiP E{F.ws, F.in, F.lds, l};
          pg8::gemm_phase<false>(F.tid, F.lds, (const char*)WSP(bf16_t, WS_HZ), D, S, E); }
        PH_LAUNDER
        { pg8::DenseSched S; S.init(T, 4096, D / 2, D / 2, F.ws + WS_WMG8 + (size_t)l * 4096 * D, F.G, F.G - 1 - F.bid, l == DEPTH - 1);
          pg8::EpiGates E{WSP(bf16_t, WS_GATES), GIN(F.in, I_BMG) + (size_t)l * 4096};
          pg8::gemm_phase<true>(F.tid, F.lds, (const char*)(F.ws + WS_HZ8), D / 2, S, E); }
)
    RUN_PHASE(base + 2, 2, phase_seqprep(F, l);)
    RUN_PHASE(base + 3, 3, phase_mixers(F, l, rep_);)
    RUN_PHASE(base + 4, 5, pg8::BranchSched S; S.init(l == DEPTH - 1, WSP(bf16_t, WS_WBT) + (size_t)l * 4 * D * 512, F.G, F.bid);
        pg8::EpiBranch E{WSP(bf16_t, WS_GATES), F.ws + WS_P};
        pg8::gemm_phase<false>(F.tid, F.lds, (const char*)WSP(bf16_t, WS_YS), 512, S, E);)
    RUN_PHASE(base + 5, 13, phase_sum4(F, l);)
    RUN_PHASE(base + 6, 6, pg8::DenseSched S; S.init(T, D, D, D, WSP(bf16_t, WS_WOT) + (size_t)l * D * D, F.G, F.bid, l == DEPTH - 1);
        pg8::EpiOut E{GIN(F.in, I_X), GIN(F.in, I_CTX), WSP(bf16_t, WS_XRES), WSP(float, WS_MOD) + (size_t)l * 9 * 6144, l};
        pg8::gemm_phase<false>(F.tid, F.lds, (const char*)WSP(bf16_t, WS_MIXED), D, S, E);)
    RUN_PHASE(base + 7, 7, phase_route(F, l);)
    RUN_PHASE(base + 8, 8, moe_prefix(F, l);
        pg8::MoeSched<8, 2048, true> S{(const LAS int*)(F.lds + LDS_MISC), F.G, F.bid, (const char*)(F.ws + WS_WGU + (size_t)l * NE * 2048 * D), WSP(int, WS_AMAP) + (size_t)l * NE * AMAX};
        pg8::EpiGU E{WSP(int, WS_AMAP) + (size_t)l * NE * AMAX, GIN(F.in, I_BGU) + (size_t)l * NE * 2048, WSP(bf16_t, WS_YBUF)};
        pg8::gemm_phase<true>(F.tid, F.lds, (const char*)WSP(bf16_t, WS_HZ), D / 2, S, E);)
    RUN_PHASE(base + 9, 9, moe_prefix(F, l);
        pg8::MoeSched<4, 1024, false> S{(const LAS int*)(F.lds + LDS_MISC), F.G, F.bid, (const char*)(F.ws + WS_WDN + (size_t)l * NE * D * D), WSP(int, WS_AMAP) + (size_t)l * NE * AMAX};
        pg8::EpiDown E{WSP(int, WS_AMAP) + (size_t)l * NE * AMAX, GIN(F.in, I_BDN) + (size_t)l * NE * D, F.ws + WS_OBUF};
        pg8::gemm_phase<true>(F.tid, F.lds, (const char*)WSP(bf16_t, WS_YBUF), D / 2, S, E);)
}
__global__ void __launch_bounds__(512, 2) fwd_mega(Params P) {
    extern __shared__ __attribute__((aligned(16))) unsigned char lds_raw[];
    Ctx F;
    cg::grid_group grid = cg::this_grid();
    if (P.ph_lo < 0) grid.sync();
    volatile LAS unsigned* bst = (volatile LAS unsigned*)((LAS unsigned char*)lds_raw + LDS_BYTES - 16);
    if (threadIdx.x < 2) bst[threadIdx.x] = 0u;
    __syncthreads();
    const XcdBarrier xb = xcd_barrier_post((unsigned*)(P.ws + WS_BAR), bst);
    RUN_PHASE(0, 10, phase_prep(F);)
    run_layer<0>(P, F, xb, lds_raw);
    run_layer<1>(P, F, xb, lds_raw);
    RUN_PHASE(N_PHASES - 1, 11, phase_final(F);)
}

#ifndef MK_MULTI
#define MK_MULTI 0
#endif
extern "C" void kernel_launch(void* const* d_in, const int* in_sizes, int n_in, void* d_out, int out_size, void* d_ws, size_t ws_size, hipStream_t stream) {
    static int grid = 0;
    if (grid == 0) {
        if (n_in != N_IN || out_size != NBATCH * SEQ * D || ws_size < WS_END) { fprintf(stderr, "kernel_launch: unexpected shapes (n_in %d out %d ws %zu need %zu)\n", n_in, out_size, ws_size, (size_t)WS_END); grid = -1; return; }
        int dev = 0, cus = 0, per_cu = 0;
        (void)hipGetDevice(&dev); (void)hipDeviceGetAttribute(&cus, hipDeviceAttributeMultiprocessorCount, dev);
        if (hipFuncSetAttribute((const void*)fwd_mega, hipFuncAttributeMaxDynamicSharedMemorySize, LDS_BYTES) != hipSuccess) { fprintf(stderr, "kernel_launch: hipFuncSetAttribute failed\n"); grid = -1; return; }
        if (hipOccupancyMaxActiveBlocksPerMultiprocessor(&per_cu, (const void*)fwd_mega, 512, LDS_BYTES) != hipSuccess || per_cu < 1) { fprintf(stderr, "kernel_launch: occupancy query failed (%d)\n", per_cu); (void)hipGetLastError(); per_cu = 1; }
        grid = cus * (per_cu > 1 ? 1 : per_cu);
        fprintf(stderr, "kernel_launch: grid %d (cus %d per_cu %d) ws need %zu have %zu\n", grid, cus, per_cu, (size_t)WS_END, ws_size);
    }
    if (grid < 0) return;
    Params p{};
    for (int i = 0; i < N_IN; ++i) p.in[i] = (const float*)d_in[i];
    p.out = (float*)d_out; p.ws = (unsigned char*)d_ws; p.G = grid; p.pad = 0;
    if (hipMemsetAsync((char*)d_ws + WS_BAR, 0, 16384, stream) != hipSuccess) { fprintf(stderr, "kernel_launch: memset failed\n"); return; }
    p.ph_lo = 0; p.ph_hi = N_PHASES;
    void* args[] = {&p};
    hipError_t e = hipLaunchCooperativeKernel((const void*)fwd_mega, dim3(grid), dim3(512), args, LDS_BYTES, stream);
    if (e != hipSuccess) fprintf(stderr, "kernel_launch: cooperative launch failed: %s (grid %d)\n", hipGetErrorString(e), grid);
}
```

```cpp
#include <hip/hip_runtime.h>
#include <hip/hip_cooperative_groups.h>
#include <cstdio>
#include <cstdint>
namespace cg = cooperative_groups;

#define LAS __attribute__((address_space(3)))
#define DI __device__ __forceinline__
typedef unsigned short bf16_t;
typedef short bf16x8 __attribute__((ext_vector_type(8)));
typedef float f32x4 __attribute__((ext_vector_type(4)));
typedef float f32x2 __attribute__((ext_vector_type(2)));
typedef unsigned u32x4 __attribute__((ext_vector_type(4)));
typedef unsigned u32x2 __attribute__((ext_vector_type(2)));
typedef int i32x4 __attribute__((ext_vector_type(4)));
typedef int i32x8 __attribute__((ext_vector_type(8)));
constexpr int FP8_WSHIFT = 7, FP8_WSCALE = 127 - FP8_WSHIFT;

constexpr int D = 1024, NBATCH = 8, SEQ = 2048, CTX = 256, LTOK = SEQ + CTX, T = NBATCH * LTOK, DEPTH = 2;
constexpr int GRID_W = 64, GRID_R = 32;
constexpr int PW = 6400;
constexpr int NG1 = 6400 + 4096;
constexpr int NE = 32, TOPK = 4, A_TOT = T * TOPK, AMAX = T;
constexpr int YSW = 2048;
constexpr int C_NAQ = 0, C_NAK = 512, C_NAV = 1024, C_RQ = 1536, C_RK = 1792, C_RV = 2048, C_RG = 2560, C_DFQ = 3072, C_DFK = 3584, C_DFV = 4096,
              C_DNQ = 4608, C_DNK = 4864, C_DNV = 5120, C_DNG = 5632;
constexpr float EPS = 1e-6f;

enum { I_X = 0, I_C, I_CTX, I_CCTX, I_WADA, I_BADA, I_NMIX, I_NFFN, I_WIN, I_NAQKG, I_NARPB, I_RETDEC, I_RETGN, I_DFQKG, I_DFLAM, I_DFSUB, I_DNCONV, I_DNALOG,
       I_DNDT, I_DNNORM, I_WBR, I_WMG, I_BMG, I_WOUT, I_RW, I_RB, I_WGU, I_BGU, I_WDN, I_BDN, N_IN };

constexpr size_t al256(size_t x) { return (x + 255) & ~(size_t)255; }
constexpr size_t WS_W1T = 0;
constexpr size_t WS_WBT = WS_W1T + al256((size_t)2 * NG1 * D * 2);
constexpr size_t WS_WOT = WS_WBT + al256((size_t)2 * 4 * D * 512 * 2);
constexpr size_t WS_WGU = WS_WOT + al256((size_t)2 * D * D * 2);
constexpr size_t WS_WDN = WS_WGU + al256((size_t)2 * NE * 2048 * D * 2);
constexpr size_t WS_MOD = WS_WDN + al256((size_t)2 * NE * D * D * 2);
constexpr size_t WS_ROPE = WS_MOD + al256((size_t)2 * 9 * 6144 * 4);
constexpr size_t ROPE_FLOATS = 2 * 2048 * 32 + 2 * 32 * 16 + 2 * 64 * 16;
constexpr size_t WS_CNT = WS_ROPE + al256(ROPE_FLOATS * 4);
constexpr size_t WS_AMAP = WS_CNT + 256;
constexpr size_t WS_GATEB = WS_AMAP + al256((size_t)2 * NE * AMAX * 4);
constexpr size_t WS_HZ = WS_GATEB + al256((size_t)2 * A_TOT * 4);
constexpr size_t WS_XRES = WS_HZ + al256((size_t)(T + 256) * D * 2);
constexpr size_t WS_AB = WS_XRES + al256((size_t)T * D * 4);
constexpr size_t WS_OSEQ = WS_AB + al256((size_t)T * 16 * 4);
constexpr size_t WS_YS = WS_OSEQ + al256((size_t)4 * T * 512 * 4);
constexpr size_t WS_MIXED = WS_YS + al256((size_t)T * YSW * 2);
constexpr size_t WS_P = WS_MIXED + al256((size_t)T * D * 2);
constexpr size_t WS_GATES = WS_P + al256((size_t)T * PW * 2);
constexpr int NCHUNK = LTOK / 64, NSEQ = 2 * NBATCH * 4 * 2, NCI = NSEQ * NCHUNK;
constexpr size_t WS_SEQT = WS_GATES + al256((size_t)T * 4096 * 2);
constexpr size_t WS_SEQU = WS_SEQT + (size_t)NCI * 32768;
constexpr size_t WS_SEQG = WS_SEQU + (size_t)NCI * 16384;
constexpr size_t WS_HZ8 = WS_SEQG + al256((size_t)NCI * 4);
constexpr size_t WS_WMG8 = WS_HZ8 + al256((size_t)T * D);
constexpr size_t WS_WAB = WS_WMG8 + al256((size_t)2 * 4096 * D);
constexpr size_t WS_RWT = WS_WAB + al256((size_t)2 * 16 * D * 4);
constexpr size_t WS_BAR = WS_RWT + al256((size_t)2 * NE * D * 4);
constexpr size_t WS_END = WS_BAR + 16384;
constexpr size_t WS_YBUF = WS_P;
constexpr size_t WS_OBUF = WS_YBUF + al256((size_t)(A_TOT + 1) * D * 2);
static_assert(WS_OBUF + (size_t)(A_TOT + 1) * D * 2 <= WS_END, "moe overlay");

constexpr int LDS_RING = 131072;
constexpr int LDS_MISC = LDS_RING;
constexpr int LDS_BYTES = 147456;

DI float bf2f(bf16_t b) { return __uint_as_float(((unsigned)b) << 16); }
DI unsigned f2bf(float f) { unsigned u = __float_as_uint(f); return (u + 0x7fffu + ((u >> 16) & 1u)) >> 16; }
DI unsigned pk2(float lo, float hi);
typedef __bf16 bf2_t __attribute__((ext_vector_type(2)));
DI unsigned cvt_pk_bf16(float lo, float hi) { const bf2_t r = __builtin_convertvector((f32x2){lo, hi}, bf2_t); return __builtin_bit_cast(unsigned, r); }
DI unsigned hw_lane() { return __builtin_amdgcn_mbcnt_hi(~0u, __builtin_amdgcn_mbcnt_lo(~0u, 0u)); }
template <int MASK> DI unsigned xshfl_u(unsigned u) {
    if constexpr (MASK == 1) return __builtin_amdgcn_update_dpp(u, u, 0xB1, 0xF, 0xF, false);
    else if constexpr (MASK == 2) return __builtin_amdgcn_update_dpp(u, u, 0x4E, 0xF, 0xF, false);
    else if constexpr (MASK == 4) { const unsigned a = __builtin_amdgcn_update_dpp(u, u, 0x141, 0xF, 0xF, false); return __builtin_amdgcn_update_dpp(a, a, 0x1B, 0xF, 0xF, false); }
    else if constexpr (MASK == 8) { const unsigned a = __builtin_amdgcn_update_dpp(u, u, 0x140, 0xF, 0xF, false); return __builtin_amdgcn_update_dpp(a, a, 0x141, 0xF, 0xF, false); }
    else if constexpr (MASK == 16) { const auto r = __builtin_amdgcn_permlane16_swap(u, u, false, false); return (hw_lane() & 16) ? r[0] : r[1]; }
    else { static_assert(MASK == 32, "xshfl mask"); const auto r = __builtin_amdgcn_permlane32_swap(u, u, false, false); return (hw_lane() & 32) ? r[0] : r[1]; }
}
template <int MASK> DI float xshfl(float v) { return __uint_as_float(xshfl_u<MASK>(__float_as_uint(v))); }
template <int MASK> DI int xshfl(int v) { return (int)xshfl_u<MASK>((unsigned)v); }
DI unsigned pk2(float lo, float hi) { return cvt_pk_bf16(lo, hi); }
DI float wave_sum(float v) { v += xshfl<1>(v); v += xshfl<2>(v); v += xshfl<4>(v); v += xshfl<8>(v); v += xshfl<16>(v); v += xshfl<32>(v); return v; }
DI float sigmoidf_(float x) { return __builtin_amdgcn_rcpf(1.f + __expf(-x)); }
DI float siluf_(float x) { return x * __builtin_amdgcn_rcpf(1.f + __expf(-x)); }
DI void unpack8(const u32x4 w, float (&f)[8]) {
    f[0] = __uint_as_float(w.x << 16); f[1] = __uint_as_float(w.x & 0xffff0000u); f[2] = __uint_as_float(w.y << 16); f[3] = __uint_as_float(w.y & 0xffff0000u);
    f[4] = __uint_as_float(w.z << 16); f[5] = __uint_as_float(w.z & 0xffff0000u); f[6] = __uint_as_float(w.w << 16); f[7] = __uint_as_float(w.w & 0xffff0000u);
}
DI unsigned pk4_fp8(float a, float b, float c, float d) { unsigned r = 0; r = __builtin_amdgcn_cvt_pk_fp8_f32(fminf(fmaxf(a, -448.f), 448.f), fminf(fmaxf(b, -448.f), 448.f), r, false); r = __builtin_amdgcn_cvt_pk_fp8_f32(fminf(fmaxf(c, -448.f), 448.f), fminf(fmaxf(d, -448.f), 448.f), r, true); return r; }
DI u32x2 pack8_fp8(const float (&f)[8]) { u32x2 w; w.x = pk4_fp8(f[0], f[1], f[2], f[3]); w.y = pk4_fp8(f[4], f[5], f[6], f[7]); return w; }
DI f32x4 unpack4(const u32x2 w) { return (f32x4){__uint_as_float(w.x << 16), __uint_as_float(w.x & 0xffff0000u), __uint_as_float(w.y << 16), __uint_as_float(w.y & 0xffff0000u)}; }
DI u32x2 pack4(const f32x4 v) { u32x2 w; w.x = pk2(v[0], v[1]); w.y = pk2(v[2], v[3]); return w; }
DI u32x4 pack8(const float (&f)[8]) { u32x4 w; w.x = pk2(f[0], f[1]); w.y = pk2(f[2], f[3]); w.z = pk2(f[4], f[5]); w.w = pk2(f[6], f[7]); return w; }

constexpr float G8S = 8.f;
constexpr float O8S = 16.f;
typedef const float* cfp_t;
#define GIN(inp, i) ((const float*)(const __attribute__((address_space(1))) float*)(inp)[i])
struct Params { const float* in[N_IN]; float* out; unsigned char* ws; int ph_lo, ph_hi, G, pad; };

namespace pg8 {
constexpr int BM = 256, BK = 64, HALF = 128, HTB = HALF * BK * 2, NXCD = 8, WGM = 8;
DI int lds_byte(int r, int c) { const int st = (r >> 4) * 2 + (c >> 5), rr = r & 15, cc = c & 31, ob = rr * 64 + cc * 2; return st * 1024 + (ob ^ (((ob >> 9) & 1) << 5)); }
DI void stage_rc(int b, int& R, int& C) { const int st = b / 1024, sb = b % 1024, swz = sb ^ (((sb >> 9) & 1) << 5); R = (st >> 1) * 16 + swz / 64; C = (st & 1) * 32 + (swz % 64) / 2; }
DI int perm32(int rho) { const int n = rho >> 4, i = rho & 15; return 8 * (i >> 2) + 4 * n + (i & 3); }
struct Unit { int pm, pn, aux; };

template <bool FP8, class Epi, class Sched>
DI void gemm_phase(const int tid, LAS unsigned char* lds, const char* Abase, const int K, const Sched& S, const Epi& E) {
    const int wid = __builtin_amdgcn_readfirstlane(tid >> 6), lane = tid & 63, wr = wid >> 2, wc = wid & 3, fr = lane & 15, fq = lane >> 4;
    const int nt = K / BK;
    unsigned voffB[2];
#pragma unroll
    for (int i = 0; i < 2; ++i) { int R, C; stage_rc(tid * 16 + i * 8192, R, C); const int Rb = (R & ~31) + perm32(R & 31); voffB[i] = (unsigned)(Rb * K + C) * 2u; }
    const size_t kstep = (size_t)(BK * 2);
    const size_t hstepB = (size_t)HALF * K * 2;
    const unsigned ldsw = (unsigned)wid * 1024u;
    const int aoff = lds_byte(wr * 64 + fr, fq * 8), boff = lds_byte(wc * 32 + fr, fq * 8);
#define PG8_SA(b, h) (((b) * 2 + (h)) * HTB)
#define PG8_SB(b, h) ((4 + (b) * 2 + (h)) * HTB)
#define PG8_STAGE2(bufoff, gbase, o0, o1) do { \
        __builtin_amdgcn_global_load_lds((const unsigned*)((const char*)(gbase) + (o0)), (LAS unsigned*)(lds + (bufoff) + ldsw), 16, 0, 0); \
        __builtin_amdgcn_global_load_lds((const unsigned*)((const char*)(gbase) + (o1)), (LAS unsigned*)(lds + (bufoff) + ldsw + 8192), 16, 0, 0); } while (0)
#define PG8_STAGEB(bufoff, gbase) PG8_STAGE2(bufoff, gbase, voffB[0], voffB[1])
#define PG8_LD8(p) __builtin_shufflevector(*(const LAS i32x4*)(p), *(const LAS i32x4*)((p) + 1024), 0, 1, 2, 3, 4, 5, 6, 7)
#define PG8_LDA(dst, b, h) do { _Pragma("unroll") for (int m = 0; m < 4; ++m) { if constexpr (FP8) dst[m].w = PG8_LD8(lds + PG8_SA(b, h) + aoff + m * 2048); else { _Pragma("unroll") for (int k = 0; k < 2; ++k) dst[m].v2[k] = *(const LAS bf16x8*)(lds + PG8_SA(b, h) + aoff + m * 2048 + k * 1024); } } } while (0)
#define PG8_LDB(dst, b, h) do { _Pragma("unroll") for (int n = 0; n < 2; ++n) { if constexpr (FP8) dst[n].w = PG8_LD8(lds + PG8_SB(b, h) + boff + n * 2048); else { _Pragma("unroll") for (int k = 0; k < 2; ++k) dst[n].v2[k] = *(const LAS bf16x8*)(lds + PG8_SB(b, h) + boff + n * 2048 + k * 1024); } } } while (0)
#define PG8_MMA(ai, bj, At, Bt) do { __builtin_amdgcn_s_setprio(1); _Pragma("unroll") for (int m = 0; m < 4; ++m) _Pragma("unroll") for (int n = 0; n < 2; ++n) { \
        if constexpr (FP8) acc[ai][bj][m][n] = __builtin_amdgcn_mfma_scale_f32_16x16x128_f8f6f4(Bt[n].w, At[m].w, acc[ai][bj][m][n], 0, 0, 0, FP8_WSCALE, 0, 127); \
        else { _Pragma("unroll") for (int k = 0; k < 2; ++k) acc[ai][bj][m][n] = __builtin_amdgcn_mfma_f32_16x16x32_bf16(Bt[n].v2[k], At[m].v2[k], acc[ai][bj][m][n], 0, 0, 0); } } __builtin_amdgcn_s_setprio(0); } while (0)
#define PG8_WAIT_V(n) asm volatile("s_waitcnt vmcnt(" #n ")" ::: "memory")
#define PG8_WAIT_L(n) asm volatile("s_waitcnt lgkmcnt(" #n ")" ::: "memory")
#define PG8_BAR __builtin_amdgcn_s_barrier()
#define PG8_SCHED __builtin_amdgcn_sched_barrier(0)
    Unit cur, nxt; int ui = 0;
    if (!S.next(0, cur)) return;
    f32x4 acc[2][2][4][2];
#pragma unroll
    for (int a = 0; a < 2; ++a)
#pragma unroll
        for (int b = 0; b < 2; ++b)
#pragma unroll
            for (int m = 0; m < 4; ++m)
#pragma unroll
                for (int n = 0; n < 2; ++n) acc[a][b][m][n] = (f32x4){0.f, 0.f, 0.f, 0.f};
    union Frag { bf16x8 v2[2]; i32x8 w; };
    Frag At[4], B0[2], B1[2];
    unsigned oc[2][2];
    S.a_off(tid, cur, oc);
    const char* cB = S.b_ptr(cur);
    const char* cA = Abase;
    PG8_STAGEB(PG8_SB(0, 0), cB); PG8_STAGEB(PG8_SB(0, 1), cB + hstepB); PG8_STAGE2(PG8_SA(0, 0), cA, oc[0][0], oc[0][1]); PG8_STAGE2(PG8_SA(0, 1), cA, oc[1][0], oc[1][1]);
    if (wr == 1) PG8_BAR;
    PG8_WAIT_V(2); PG8_BAR;
    PG8_STAGEB(PG8_SB(1, 0), cB + kstep); PG8_STAGE2(PG8_SA(1, 0), cA + kstep, oc[0][0], oc[0][1]); PG8_STAGEB(PG8_SB(1, 1), cB + hstepB + kstep);
    PG8_WAIT_V(6); PG8_BAR;
    for (;;) {
        const bool has_next = S.next(ui + 1, nxt);
        const char* nB = cB;
        if (has_next) nB = S.b_ptr(nxt);
#pragma unroll 1
        for (int t = 0; t < nt; t += 2) {
            const bool last = (t == nt - 2);
            const char* a1 = cA + (size_t)(t + 1) * kstep;
            const char* a2 = last ? cA : cA + (size_t)(t + 2) * kstep; const char* b2 = last ? nB : cB + (size_t)(t + 2) * kstep;
            const char* a3 = a2 + kstep; const char* b3 = b2 + kstep;
            PG8_LDB(B0, 0, 0); PG8_LDB(B1, 0, 1); PG8_SCHED; PG8_LDA(At, 0, 0); PG8_STAGE2(PG8_SA(1, 1), a1, oc[1][0], oc[1][1]);
            if (last && has_next && S.a_changes(cur, nxt)) S.a_off(tid, nxt, oc);
            PG8_WAIT_V(8); PG8_WAIT_L(0); PG8_BAR; PG8_MMA(0, 0, At, B0); PG8_MMA(0, 1, At, B1); PG8_BAR; PG8_SCHED;
            PG8_LDA(At, 0, 1); PG8_STAGEB(PG8_SB(0, 0), b2); PG8_STAGEB(PG8_SB(0, 1), b2 + hstepB); PG8_STAGE2(PG8_SA(0, 0), a2, oc[0][0], oc[0][1]);
            PG8_WAIT_V(8); PG8_WAIT_L(0); PG8_BAR; PG8_MMA(1, 0, At, B0); PG8_MMA(1, 1, At, B1); PG8_BAR; PG8_SCHED;
            PG8_LDB(B0, 1, 0); PG8_LDB(B1, 1, 1); PG8_SCHED; PG8_LDA(At, 1, 0); PG8_STAGE2(PG8_SA(0, 1), a2, oc[1][0], oc[1][1]);
            PG8_WAIT_V(8); PG8_WAIT_L(0); PG8_BAR; PG8_MMA(0, 0, At, B0); PG8_MMA(0, 1, At, B1); PG8_BAR; PG8_SCHED;
            PG8_LDA(At, 1, 1); PG8_STAGEB(PG8_SB(1, 0), b3); PG8_STAGEB(PG8_SB(1, 1), b3 + hstepB); PG8_STAGE2(PG8_SA(1, 0), a3, oc[0][0], oc[0][1]);
            PG8_WAIT_V(8); PG8_WAIT_L(0); PG8_BAR; PG8_MMA(1, 0, At, B0); PG8_MMA(1, 1, At, B1); PG8_BAR; PG8_SCHED;
        }
        if (wr == 0) PG8_BAR;
        { int fr2 = fr, fq2 = fq; asm volatile("" : "+v"(fr2), "+v"(fq2));
          E(acc, cur, wr, wc, fr2, fq2); }
        if (!has_next) break;
#pragma unroll
        for (int a = 0; a < 2; ++a)
#pragma unroll
            for (int b = 0; b < 2; ++b)
#pragma unroll
                for (int m = 0; m < 4; ++m)
#pragma unroll
                    for (int n = 0; n < 2; ++n) acc[a][b][m][n] = (f32x4){0.f, 0.f, 0.f, 0.f};
        cur = nxt; cB = nB; ++ui;
        if (wr == 1) PG8_BAR;
    }
    PG8_WAIT_V(0);
    PG8_BAR;
#undef PG8_SA
#undef PG8_SB
#undef PG8_STAGE2
#undef PG8_STAGEB
#undef PG8_LDA
#undef PG8_LDB
#undef PG8_MMA
#undef PG8_WAIT_V
#undef PG8_WAIT_L
#undef PG8_BAR
#undef PG8_SCHED
}

struct DenseSched {
    int nM, nN, nwg, G, c, lda, K, i0 = 0, i1 = 1 << 30; bool lat; const char* Bt;
    DI void init(int M, int N, int K_, int lda_, const void* Bt_, int G_, int c_, bool lat_ = false) { lat = lat_; nM = lat_ ? NBATCH * 8 : M / BM; nN = N / BM; nwg = nM * nN; G = G_; c = c_; lda = lda_; K = K_; Bt = (const char*)Bt_; }
    DI bool next(int i, Unit& u) const {
        if (i + i0 >= i1) return false;
        const long L = (long)(i + i0) * G + c; if (L >= nwg) return false;
        int wgid = (int)L; { const int q = nwg / NXCD, r = nwg % NXCD, xcd = wgid % NXCD, off = wgid / NXCD; wgid = (xcd < r ? xcd * (q + 1) : r * (q + 1) + (xcd - r) * q) + off; }
        const int nig = WGM * nN, gid = wgid / nig, fm = gid * WGM, gsz = (nM - fm) < WGM ? (nM - fm) : WGM;
        u.pm = fm + ((wgid % nig) % gsz); u.pn = (wgid % nig) / gsz; u.aux = 0; if (lat) u.pm = (u.pm >> 3) * 9 + 1 + (u.pm & 7); return true;
    }
    DI bool a_changes(const Unit& a, const Unit& b) const { return a.pm != b.pm; }
    DI const char* b_ptr(const Unit& u) const { return Bt + (size_t)u.pn * BM * K * 2; }
    DI void a_off(const int tid, const Unit& u, unsigned (&off)[2][2]) const {
#pragma unroll
        for (int i = 0; i < 2; ++i) { int R, C; stage_rc(tid * 16 + i * 8192, R, C);
#pragma unroll
            for (int h = 0; h < 2; ++h) off[h][i] = (unsigned)((u.pm * BM + h * HALF + R) * lda + C) * 2u; }
    }
};
struct BranchSched {
    int nM, nwg, G, c; bool lat; const char* Bt;
    DI void init(bool lat_, const void* Bt_, int G_, int c_) { lat = lat_; nM = lat_ ? NBATCH * 8 : T / BM; nwg = nM * 16; G = G_; c = c_; Bt = (const char*)Bt_; }
    DI bool next(int i, Unit& u) const {
        int L = i * G + c; if (L >= nwg) return false;
        if ((G & 7) == 0 && (nwg & 31) == 0) {
            const int x = c & 7, k = i * (G >> 3) + (c >> 3), g = (k >> 2) * 8 + x;
            L = g * 4 + (k & 3); }
        const int pmv = L >> 4; u.pm = lat ? (pmv >> 3) * 9 + 1 + (pmv & 7) : pmv; u.pn = L & 3; u.aux = (L >> 2) & 3; return true;
    }
    DI bool a_changes(const Unit& a, const Unit& b) const { return a.pm != b.pm || a.aux != b.aux; }
    DI const char* b_ptr(const Unit& u) const { return Bt + ((size_t)u.aux * D + (size_t)u.pn * BM) * 512 * 2; }
    DI void a_off(const int tid, const Unit& u, unsigned (&off)[2][2]) const {
#pragma unroll
        for (int i = 0; i < 2; ++i) { int R, C; stage_rc(tid * 16 + i * 8192, R, C);
#pragma unroll
            for (int h = 0; h < 2; ++h) off[h][i] = (unsigned)((u.pm * BM + h * HALF + R) * YSW + u.aux * 512 + C) * 2u; }
    }
};
template <int NT, int NROWS, bool TOKROWS>
struct MoeSched {
    const LAS int* pref; int G, c; const char* Bt; const int* amap;
    DI bool next(int i, Unit& u) const {
        const int L = i * G + c; const int total = pref[NE] * NT; if (L >= total) return false;
        const int mtg = L / NT;
        const unsigned ln = hw_lane(); const int pv = pref[ln <= (unsigned)NE ? ln : (unsigned)NE];
        const int e = __builtin_popcountll(__builtin_amdgcn_ballot_w64(ln >= 1u && ln <= (unsigned)NE && pv <= mtg));
        u.aux = e; u.pm = mtg - pref[e]; u.pn = L % NT; return true;
    }
    DI bool a_changes(const Unit& a, const Unit& b) const { return a.pm != b.pm || a.aux != b.aux; }
    DI const char* b_ptr(const Unit& u) const { return Bt + ((size_t)u.aux * NROWS + (size_t)u.pn * BM) * D; }
    DI void a_off(const int tid, const Unit& u, unsigned (&off)[2][2]) const {
#pragma unroll
        for (int i = 0; i < 2; ++i) { int R, C; stage_rc(tid * 16 + i * 8192, R, C);
#pragma unroll
            for (int h = 0; h < 2; ++h) { int rid = amap[(size_t)u.aux * AMAX + u.pm * BM + h * HALF + R]; if (TOKROWS) rid >>= 2; off[h][i] = (unsigned)(rid * (D / 2) + C) * 2u; } }
    }
};

struct EpiP {
    unsigned char* ws; const __attribute__((address_space(4))) cfp_t* in; LAS unsigned char* ldsb; int layer;
    DI void operator()(const f32x4 (&acc)[2][2][4][2], const Unit& u, int wr, int wc, int fr, int fq) const {
        bf16_t* p = (bf16_t*)(ws + WS_P); const float* rope = (const float*)(ws + WS_ROPE); LAS float* ex = (LAS float*)(ldsb + LDS_MISC);
        const float* gna = GIN(in, I_NAQKG) + (size_t)layer * 128; const float* gdf = GIN(in, I_DFQKG) + (size_t)layer * 128;
        const int row0 = u.pm * BM + wr * 64 + fr, cl = wc * 32 + 8 * fq;
        const int kind = u.pn < 4 ? (u.pn >> 1) : ((u.pn >= 12 && u.pn < 16) ? 2 + ((u.pn - 12) >> 1) : -1);
        if (kind < 0) {
#pragma unroll
            for (int ai = 0; ai < 2; ++ai)
#pragma unroll
                for (int m = 0; m < 4; ++m) { bf16_t* rowp = p + (size_t)(row0 + ai * HALF + m * 16) * PW + u.pn * BM + cl;
#pragma unroll
                    for (int bj = 0; bj < 2; ++bj) { const f32x4 v0 = acc[ai][bj][m][0], v1 = acc[ai][bj][m][1]; u32x4 w; w.x = cvt_pk_bf16(v0[0], v0[1]); w.y = cvt_pk_bf16(v0[2], v0[3]); w.z = cvt_pk_bf16(v1[0], v1[1]); w.w = cvt_pk_bf16(v1[2], v1[3]);
                        *(u32x4*)(rowp + bj * HALF) = w; } }
            return;
        }
        const float* gp = (kind < 2 ? gna : gdf) + (kind & 1) * 64 + (wc & 1) * 32 + 8 * fq;
        const f32x4 g0 = *(const f32x4*)gp, g1 = *(const f32x4*)(gp + 4);
        const float post = (kind & 1) ? 1.f : 0.125f * 1.4426950408889634f;
        const float *cos_r = rope + 2 * 2048 * 32, *sin_r = cos_r + 512, *cos_c = cos_r + 1024, *sin_c = cos_c + 1024;
#pragma unroll
        for (int bj = 0; bj < 2; ++bj) {
            float ss[2][4];
#pragma unroll
            for (int ai = 0; ai < 2; ++ai)
#pragma unroll
                for (int m = 0; m < 4; ++m) { const f32x4 v0 = acc[ai][bj][m][0], v1 = acc[ai][bj][m][1];
                    float q = v0[0] * v0[0] + v0[1] * v0[1] + v0[2] * v0[2] + v0[3] * v0[3] + v1[0] * v1[0] + v1[1] * v1[1] + v1[2] * v1[2] + v1[3] * v1[3];
                    q += xshfl<16>(q); q += xshfl<32>(q); ss[ai][m] = q;
                    if (fq == 0) ex[((wr * 4 + wc) * 8 + ai * 4 + m) * 16 + fr] = q; }
            __syncthreads();
#pragma unroll
            for (int ai = 0; ai < 2; ++ai)
#pragma unroll
                for (int m = 0; m < 4; ++m) ss[ai][m] += ex[((wr * 4 + (wc ^ 1)) * 8 + ai * 4 + m) * 16 + fr];
            __syncthreads();
#pragma unroll
            for (int ai = 0; ai < 2; ++ai)
#pragma unroll
                for (int m = 0; m < 4; ++m) { const int row = row0 + ai * HALF + m * 16; const float rn = rsqrtf(ss[ai][m] * (1.f / 64.f) + EPS) * post;
                    f32x4 v0 = acc[ai][bj][m][0] * rn * g0, v1 = acc[ai][bj][m][1] * rn * g1;
                    if (kind >= 2) { const int b = row / LTOK, pos = row - b * LTOK;
                        f32x4 p0, p1;
#pragma unroll
                        for (int j = 0; j < 4; ++j) { p0[j] = xshfl<32>(v0[j]); p1[j] = xshfl<32>(v1[j]); }
                        if (pos >= CTX) { const int li = pos - CTX; const float* ct = (wc & 1) ? cos_c + (li & 63) * 16 : cos_r + (li >> 6) * 16; const float* st = (wc & 1) ? sin_c + (li & 63) * 16 : sin_r + (li >> 6) * 16;
                            const int f0 = 8 * (fq & 1); const f32x4 c0 = *(const f32x4*)(ct + f0), c1 = *(const f32x4*)(ct + f0 + 4), s0 = *(const f32x4*)(st + f0), s1 = *(const f32x4*)(st + f0 + 4);
                            if (fq < 2) { v0 = v0 * c0 - p0 * s0; v1 = v1 * c1 - p1 * s1; } else { v0 = v0 * c0 + p0 * s0; v1 = v1 * c1 + p1 * s1; } } }
                    u32x4 w; w.x = cvt_pk_bf16(v0[0], v0[1]); w.y = cvt_pk_bf16(v0[2], v0[3]); w.z = cvt_pk_bf16(v1[0], v1[1]); w.w = cvt_pk_bf16(v1[2], v1[3]);
                    *(u32x4*)(p + (size_t)row * PW + u.pn * BM + cl + bj * HALF) = w;
                    asm volatile("" ::: "memory"); }
        }
    }
};
struct EpiGates {
    bf16_t* gates; const float* bmg;
    DI void operator()(const f32x4 (&acc)[2][2][4][2], const Unit& u, int wr, int wc, int fr, int fq) const {
        const int row0 = u.pm * BM + wr * 64 + fr, gc0 = u.pn * BM + wc * 32 + 8 * fq;
        f32x4 bv[2][2];
#pragma unroll
        for (int bj = 0; bj < 2; ++bj)
#pragma unroll
            for (int n = 0; n < 2; ++n) bv[bj][n] = *(const f32x4*)(bmg + gc0 + bj * HALF + 4 * n);
#pragma unroll
        for (int ai = 0; ai < 2; ++ai)
#pragma unroll
            for (int m = 0; m < 4; ++m) { bf16_t* rowp = gates + (size_t)(row0 + ai * HALF + m * 16) * 4096 + gc0;
#pragma unroll
                for (int bj = 0; bj < 2; ++bj) { f32x4 v0 = acc[ai][bj][m][0] + bv[bj][0], v1 = acc[ai][bj][m][1] + bv[bj][1];
#pragma unroll
                    for (int j = 0; j < 4; ++j) { v0[j] = sigmoidf_(v0[j]); v1[j] = sigmoidf_(v1[j]); }
                    u32x4 w; w.x = cvt_pk_bf16(v0[0], v0[1]); w.y = cvt_pk_bf16(v0[2], v0[3]); w.z = cvt_pk_bf16(v1[0], v1[1]); w.w = cvt_pk_bf16(v1[2], v1[3]);
                    *(u32x4*)(rowp + bj * HALF) = w; } }
    }
};
struct EpiBranch {
    const bf16_t* gates; unsigned char* Gout;
    DI void operator()(const f32x4 (&acc)[2][2][4][2], const Unit& u, int wr, int wc, int fr, int fq) const {
        const int row0 = u.pm * BM + wr * 64 + fr, col0 = u.aux * D + u.pn * BM + wc * 32 + 8 * fq;
#pragma unroll
        for (int ai = 0; ai < 2; ++ai) {
            u32x4 gv[4][2];
#pragma unroll
            for (int m = 0; m < 4; ++m)
#pragma unroll
                for (int bj = 0; bj < 2; ++bj) gv[m][bj] = *(const u32x4*)(gates + (size_t)(row0 + ai * HALF + m * 16) * 4096 + col0 + bj * HALF);
#pragma unroll
            for (int m = 0; m < 4; ++m) { const size_t row = (size_t)(row0 + ai * HALF + m * 16);
#pragma unroll
                for (int bj = 0; bj < 2; ++bj) { const int col = col0 + bj * HALF;
                    float g[8]; unpack8(gv[m][bj], g);
                    const f32x4 v0 = acc[ai][bj][m][0], v1 = acc[ai][bj][m][1];
                    u32x2 w; w.x = pk4_fp8(v0[0] * g[0] * G8S, v0[1] * g[1] * G8S, v0[2] * g[2] * G8S, v0[3] * g[3] * G8S); w.y = pk4_fp8(v1[0] * g[4] * G8S, v1[1] * g[5] * G8S, v1[2] * g[6] * G8S, v1[3] * g[7] * G8S);
                    *(u32x2*)(Gout + row * 4096 + col) = w; } } }
    }
};
struct EpiOut {
    const float* x; const float* ctx; bf16_t* xres; const float* mod; int layer;
    DI void operator()(const f32x4 (&acc)[2][2][4][2], const Unit& u, int wr, int wc, int fr, int fq) const {
        const int row0 = u.pm * BM + wr * 64 + fr, col0 = u.pn * BM + wc * 32 + 8 * fq;
#pragma unroll
        for (int ai = 0; ai < 2; ++ai)
#pragma unroll
            for (int mp = 0; mp < 4; mp += 2) {
                f32x4 xi[2][2][2], mgv[2][2][2];
#pragma unroll
                for (int mm = 0; mm < 2; ++mm) { const int row = row0 + ai * HALF + (mp + mm) * 16; const int b = row / LTOK, pos = row - b * LTOK;
                    const float* src = pos < CTX ? ctx + (size_t)(b * CTX + pos) * D : x + (size_t)(b * SEQ + pos - CTX) * D;
                    const float* mg = mod + (size_t)(pos < CTX ? 8 : b) * 6144 + 2 * D;
#pragma unroll
                    for (int bj = 0; bj < 2; ++bj) { const int col = col0 + bj * HALF;
                        if (layer == 0) { xi[mm][bj][0] = *(const f32x4*)(src + col); xi[mm][bj][1] = *(const f32x4*)(src + col + 4); }
                        else { const u32x4 w = *(const u32x4*)(xres + (size_t)row * D + col); u32x2 lo, hi; lo.x = w.x; lo.y = w.y; hi.x = w.z; hi.y = w.w; xi[mm][bj][0] = unpack4(lo); xi[mm][bj][1] = unpack4(hi); }
                        mgv[mm][bj][0] = *(const f32x4*)(mg + col); mgv[mm][bj][1] = *(const f32x4*)(mg + col + 4); } }
#pragma unroll
                for (int mm = 0; mm < 2; ++mm) { const int m = mp + mm, row = row0 + ai * HALF + m * 16;
#pragma unroll
                    for (int bj = 0; bj < 2; ++bj) { const int col = col0 + bj * HALF;
                        const f32x4 v0 = xi[mm][bj][0] + mgv[mm][bj][0] * acc[ai][bj][m][0], v1 = xi[mm][bj][1] + mgv[mm][bj][1] * acc[ai][bj][m][1];
                        u32x4 o; o.x = pk2(v0[0], v0[1]); o.y = pk2(v0[2], v0[3]); o.z = pk2(v1[0], v1[1]); o.w = pk2(v1[2], v1[3]);
                        *(u32x4*)(xres + (size_t)row * D + col) = o; } } }
    }
};
struct EpiGU {
    const int* amap; const float* bgu; bf16_t* ybuf;
    DI void operator()(const f32x4 (&acc)[2][2][4][2], const Unit& u, int wr, int wc, int fr, int fq) const {
        const int e = u.aux, ff0 = u.pn * 128 + wc * 32 + 8 * fq;
        const float* bg = bgu + (size_t)e * 2048 + ff0;
        f32x4 bgv[2], buv[2];
#pragma unroll
        for (int n = 0; n < 2; ++n) { bgv[n] = *(const f32x4*)(bg + 4 * n); buv[n] = *(const f32x4*)(bg + 1024 + 4 * n); }
        int aid[2][4];
#pragma unroll
        for (int ai = 0; ai < 2; ++ai)
#pragma unroll
            for (int m = 0; m < 4; ++m) aid[ai][m] = amap[(size_t)e * AMAX + u.pm * BM + ai * HALF + wr * 64 + m * 16 + fr];
#pragma unroll
        for (int ai = 0; ai < 2; ++ai)
#pragma unroll
            for (int m = 0; m < 4; ++m) { const int a = aid[ai][m];
                float y[8];
#pragma unroll
                for (int n = 0; n < 2; ++n) { const f32x4 gt = acc[ai][0][m][n] + bgv[n], up = acc[ai][1][m][n] + buv[n];
#pragma unroll
                    for (int j = 0; j < 4; ++j) { const float g = fminf(gt[j], 7.f), uu = fminf(fmaxf(up[j], -7.f), 7.f); y[4 * n + j] = (uu + 1.f) * (g * sigmoidf_(1.702f * g)); } }
                *(u32x2*)((unsigned char*)ybuf + (size_t)a * D + ff0) = pack8_fp8(y); }
    }
};
struct EpiDown {
    const int* amap; const float* bdn; unsigned char* obuf;
    DI void operator()(const f32x4 (&acc)[2][2][4][2], const Unit& u, int wr, int wc, int fr, int fq) const {
        const int e = u.aux, col0 = u.pn * BM + wc * 32 + 8 * fq;
        f32x4 bv[2][2];
#pragma unroll
        for (int bj = 0; bj < 2; ++bj)
#pragma unroll
            for (int n = 0; n < 2; ++n) bv[bj][n] = *(const f32x4*)(bdn + (size_t)e * D + col0 + bj * HALF + 4 * n);
        int aid[2][4];
#pragma unroll
        for (int ai = 0; ai < 2; ++ai)
#pragma unroll
            for (int m = 0; m < 4; ++m) aid[ai][m] = amap[(size_t)e * AMAX + u.pm * BM + ai * HALF + wr * 64 + m * 16 + fr];
#pragma unroll
        for (int ai = 0; ai < 2; ++ai)
#pragma unroll
            for (int m = 0; m < 4; ++m) { const int a = aid[ai][m];
#pragma unroll
                for (int bj = 0; bj < 2; ++bj) { const f32x4 v0 = acc[ai][bj][m][0] + bv[bj][0], v1 = acc[ai][bj][m][1] + bv[bj][1];
                    u32x2 w; w.x = pk4_fp8(v0[0] * O8S, v0[1] * O8S, v0[2] * O8S, v0[3] * O8S); w.y = pk4_fp8(v1[0] * O8S, v1[1] * O8S, v1[2] * O8S, v1[3] * O8S);
                    *(u32x2*)(obuf + (size_t)a * D + col0 + bj * HALF) = w; } }
    }
};
}

struct Ctx {
    LAS unsigned char* lds; int tid, lane, wave, G, bid;
    const __attribute__((address_space(4))) cfp_t* in; float* out; unsigned char* ws;
};
#define WSP(T_, off) ((T_*)(F.ws + (off)))

struct TrJob { const float* W; unsigned char* WT; int K, N, k0, n0, mode, f8; };
constexpr int CS_WIN = 8 * 24, CS_WMG = 8 * 16, CS_WBR = 4 * 4 * 4, CS_WO = 8 * 4, CS_GU = NE * 8 * 8, CS_DN = NE * 8 * 4, CS_L = CS_WIN + CS_WMG + CS_WBR + CS_WO + CS_GU + CS_DN;
constexpr int CV_N0 = CS_WIN + CS_WMG, CV_N1 = 2 * CS_L - CV_N0;
DI void conv_job(const Ctx& F, int it, TrJob& t) {
    const int l = it / CS_L; int r = it % CS_L; int kb, nb;
    if (r < CS_WIN) { t.W = GIN(F.in, I_WIN) + (size_t)l * D * 6160; t.K = D; t.N = 6160; t.WT = (unsigned char*)(WSP(bf16_t, WS_W1T) + (size_t)l * NG1 * D); t.mode = 0; t.f8 = 0; kb = r / 24; nb = r % 24; }
    else if ((r -= CS_WIN) < CS_WMG) { t.W = GIN(F.in, I_WMG) + (size_t)l * D * 4096; t.K = D; t.N = 4096; t.WT = F.ws + WS_WMG8 + (size_t)l * 4096 * D; t.mode = 0; t.f8 = 1; kb = r / 16; nb = r % 16; }
    else if ((r -= CS_WMG) < CS_WBR) { const int n4 = r / 16, q = r % 16; t.W = GIN(F.in, I_WBR) + ((size_t)l * 4 + n4) * 512 * D; t.K = 512; t.N = D; t.WT = (unsigned char*)(WSP(bf16_t, WS_WBT) + ((size_t)l * 4 + n4) * D * 512); t.mode = 0; t.f8 = 0; kb = q / 4; nb = q % 4; }
    else if ((r -= CS_WBR) < CS_WO) { t.W = GIN(F.in, I_WOUT) + (size_t)l * D * D; t.K = D; t.N = D; t.WT = (unsigned char*)(WSP(bf16_t, WS_WOT) + (size_t)l * D * D); t.mode = 0; t.f8 = 0; kb = r / 4; nb = r % 4; }
    else if ((r -= CS_WO) < CS_GU) { const int e = r / 64, q = r % 64; t.W = GIN(F.in, I_WGU) + ((size_t)l * NE + e) * D * 2048; t.K = D; t.N = 2048; t.WT = F.ws + WS_WGU + ((size_t)l * NE + e) * 2048 * D; t.mode = 1; t.f8 = 1; kb = q / 8; nb = q % 8; }
    else { r -= CS_GU; const int e = r / 32, q = r % 32; t.W = GIN(F.in, I_WDN) + ((size_t)l * NE + e) * D * D; t.K = D; t.N = D; t.WT = F.ws + WS_WDN + ((size_t)l * NE + e) * D * D; t.mode = 0; t.f8 = 1; kb = q / 4; nb = q % 4; }
    t.k0 = kb * 128; t.n0 = nb * 256;
}
DI void st_fetch(const TrJob& t, f32x4 (&v)[16], int lane, int wave) {
    const float* src = t.W + (size_t)(t.k0 + wave) * t.N + t.n0 + 4 * lane;
#pragma unroll
    for (int r = 0; r < 16; ++r) v[r] = __builtin_nontemporal_load((const f32x4*)(src + (size_t)(8 * r) * t.N));
}
DI void st_write(const f32x4 (&v)[16], LAS float* S, int lane, int wave) {
    __syncthreads();
#pragma unroll
    for (int r = 0; r < 16; ++r) { const int k = wave + 8 * r; *(LAS f32x4*)(S + k * 256 + 4 * (lane ^ ((k >> 4) & 7))) = v[r]; }
}
DI void st_flush(const TrJob& t, LAS float* S, int lane, int wave) {
    __syncthreads();
    if (!t.f8) {
        const int c = lane & 15, nl = lane >> 4;
#pragma unroll
        for (int j = 0; j < 8; ++j) { const int nloc = 32 * wave + nl + 4 * j, n = t.n0 + nloc;
            const LAS float* sp = S + (8 * c) * 256 + 4 * ((nloc >> 2) ^ (c >> 1)) + (nloc & 3); u32x4 o;
            o.x = pk2(sp[0], sp[256]); o.y = pk2(sp[2 * 256], sp[3 * 256]); o.z = pk2(sp[4 * 256], sp[5 * 256]); o.w = pk2(sp[6 * 256], sp[7 * 256]);
            *(u32x4*)((bf16_t*)t.WT + (size_t)n * t.K + t.k0 + 8 * c) = o; }
    } else {
        const int c = lane & 7, nl = lane >> 3; const float sc = (float)(1 << FP8_WSHIFT);
#pragma unroll
        for (int j = 0; j < 4; ++j) { const int nloc = 32 * wave + nl + 8 * j, n = t.n0 + nloc;
            int drow = n; if (t.mode == 1) { const int ff = n & 1023; drow = (ff >> 7) * 256 + (n >= 1024 ? 128 : 0) + (ff & 127); }
            const LAS float* sp = S + (16 * c) * 256 + 4 * ((nloc >> 2) ^ c) + (nloc & 3); u32x4 o;
            o.x = pk4_fp8(sp[0] * sc, sp[256] * sc, sp[2 * 256] * sc, sp[3 * 256] * sc); o.y = pk4_fp8(sp[4 * 256] * sc, sp[5 * 256] * sc, sp[6 * 256] * sc, sp[7 * 256] * sc);
            o.z = pk4_fp8(sp[8 * 256] * sc, sp[9 * 256] * sc, sp[10 * 256] * sc, sp[11 * 256] * sc); o.w = pk4_fp8(sp[12 * 256] * sc, sp[13 * 256] * sc, sp[14 * 256] * sc, sp[15 * 256] * sc);
            *(u32x4*)(t.WT + (size_t)drow * t.K + t.k0 + 16 * c) = o; }
    }
}
DI void convert_range(const Ctx& F, int first, int a, int b, int nblk, int blk) {
    int lane_; asm volatile("v_mbcnt_lo_u32_b32 %0, -1, 0\n\tv_mbcnt_hi_u32_b32 %0, -1, %0" : "=v"(lane_)); const int lane = lane_;
    LAS float* S = (LAS float*)F.lds;
    TrJob ja, jb; f32x4 va[16], vb[16];
    int j = a + blk;
    if (j < b) { conv_job(F, first + j, ja); st_fetch(ja, va, lane, F.wave); }
    if (j + nblk < b) { conv_job(F, first + j + nblk, jb); st_fetch(jb, vb, lane, F.wave); }
#pragma unroll 1
    for (; j < b; j += 2 * nblk) {
        { TrJob cur = ja; st_write(va, S, lane, F.wave);
          if (j + 2 * nblk < b) { conv_job(F, first + j + 2 * nblk, ja); st_fetch(ja, va, lane, F.wave); }
          st_flush(cur, S, lane, F.wave); }
        if (j + nblk < b) { TrJob cur = jb; st_write(vb, S, lane, F.wave);
          if (j + 3 * nblk < b) { conv_job(F, first + j + 3 * nblk, jb); st_fetch(jb, vb, lane, F.wave); }
          st_flush(cur, S, lane, F.wave); }
    }
    __syncthreads();
}
constexpr int CV_ITEM = 8, CV_NITEM = CV_N1 / CV_ITEM;
static_assert(CV_N1 % CV_ITEM == 0, "conversion items");
DI void phase_prep(const Ctx& F) {
    convert_range(F, 0, 0, CV_N0, F.G, F.bid);
    const int gt = F.bid * 512 + F.tid, NGT = F.G * 512;
    for (int i = gt; i < 256 * (D / 16); i += NGT) *(u32x4*)(F.ws + WS_HZ + (size_t)T * D + (size_t)i * 16) = (u32x4){0u, 0u, 0u, 0u};
    for (int i = gt; i < 2 * NE * AMAX; i += NGT) WSP(int, WS_AMAP)[i] = A_TOT;
    if (gt < 64) WSP(int, WS_CNT)[gt] = 0;
    for (int i = gt; i < 2 * 16 * D; i += NGT) { const int l = i / (16 * D), r = i % (16 * D), c = r / D, k = r % D; WSP(float, WS_WAB)[i] = GIN(F.in, I_WIN)[(size_t)l * D * 6160 + (size_t)k * 6160 + 6144 + c]; }
    for (int i = gt; i < 2 * NE * D; i += NGT) { const int l = i / (NE * D), r = i % (NE * D), e = r / D, k = r % D; WSP(float, WS_RWT)[i] = GIN(F.in, I_RW)[(size_t)l * D * NE + (size_t)k * NE + e]; }
    {
        float* rp = WSP(float, WS_ROPE);
        for (int i = gt; i < 2048 * 32; i += NGT) { const int t = i >> 5, f = i & 31; const float inv = powf(10000.f, -(float)(2 * f) / 64.f); float s, c; sincosf((float)t * inv, &s, &c); rp[i] = c; rp[2048 * 32 + i] = s; }
        float* rr = rp + 2 * 2048 * 32;
        for (int i = gt; i < 32 * 16; i += NGT) { const int t = i >> 4, f = i & 15; const float inv = powf(10000.f, -(float)(2 * f) / 32.f); float s, c; sincosf((float)t * inv, &s, &c); rr[i] = c; rr[512 + i] = s; }
        float* rc = rr + 1024;
        for (int i = gt; i < 64 * 16; i += NGT) { const int t = i >> 4, f = i & 15; const float inv = powf(10000.f, -(float)(2 * f) / 32.f); float s, c; sincosf((float)t * inv, &s, &c); rc[i] = c; rc[1024 + i] = s; }
    }
    __syncthreads();
    LAS float* sc = (LAS float*)F.lds;
    LAS float* red = (LAS float*)(F.lds + 40960);
    for (int i = F.tid; i < 9 * D; i += 512) { const int r = i >> 10, k = i & 1023; const float v = r < 8 ? GIN(F.in, I_C)[r * D + k] : GIN(F.in, I_CCTX)[k]; sc[i] = siluf_(v); }
    __syncthreads();
    for (int it = F.bid; it < 2 * 96; it += F.G) {
        const int l = it / 96, j0 = (it % 96) * 64;
        const float* W = GIN(F.in, I_WADA) + (size_t)l * D * 6144 + j0 + F.lane;
        float a[9];
#pragma unroll
        for (int r = 0; r < 9; ++r) a[r] = 0.f;
        const int kb = F.wave * 128;
#pragma unroll 4
        for (int k = 0; k < 128; ++k) { const float w = W[(size_t)(kb + k) * 6144];
#pragma unroll
            for (int r = 0; r < 9; ++r) a[r] += sc[r * D + kb + k] * w; }
#pragma unroll
        for (int r = 0; r < 9; ++r) red[(F.wave * 9 + r) * 64 + F.lane] = a[r];
        __syncthreads();
        for (int i = F.tid; i < 9 * 64; i += 512) { const int r = i >> 6, j = i & 63; float s = GIN(F.in, I_BADA)[(size_t)l * 6144 + j0 + j];
#pragma unroll
            for (int w = 0; w < 8; ++w) s += red[(w * 9 + r) * 64 + j];
            WSP(float, WS_MOD)[((size_t)l * 9 + r) * 6144 + j0 + j] = s; }
        __syncthreads();
    }
}

DI void moe_comb_row(const Ctx& F, int l, int m, f32x4 (&cv)[4]) {
    const float* gb = WSP(float, WS_GATEB) + (size_t)l * A_TOT + (size_t)m * 4;
    const unsigned char* ob = F.ws + WS_OBUF + (size_t)m * 4 * D;
#pragma unroll
    for (int j = 0; j < 4; ++j) cv[j] = (f32x4){0.f, 0.f, 0.f, 0.f};
#pragma unroll
    for (int k = 0; k < 4; ++k) { const float g = gb[k] * (1.f / O8S);
#pragma unroll
        for (int j = 0; j < 4; ++j) { const unsigned w = *(const unsigned*)(ob + (size_t)k * D + 4 * F.lane + 256 * j);
            const f32x2 lo = __builtin_amdgcn_cvt_pk_f32_fp8((int)w, false), hi = __builtin_amdgcn_cvt_pk_f32_fp8((int)w, true);
            cv[j][0] += g * lo[0]; cv[j][1] += g * lo[1]; cv[j][2] += g * hi[0]; cv[j][3] += g * hi[1]; } }
}
DI void phase_norm(const Ctx& F, int l) {
    const int gw = F.bid * 8 + F.wave, NGW = F.G * 8, lane = F.lane;
    const float* mod = WSP(float, WS_MOD) + (size_t)l * 9 * 6144;
    const float* gain = GIN(F.in, I_NMIX) + (size_t)l * D;
    LAS float* wab = (LAS float*)F.lds;
    { const f32x4* src = (const f32x4*)(WSP(float, WS_WAB) + (size_t)l * 16 * D); f32x4 tmp[8];
#pragma unroll
        for (int i = 0; i < 8; ++i) tmp[i] = src[F.tid + 512 * i];
#pragma unroll
        for (int i = 0; i < 8; ++i) *(LAS f32x4*)(wab + 4 * (F.tid + 512 * i)) = tmp[i]; }
    __syncthreads();
    constexpr int RT = 3;
    for (int m0 = gw; m0 < T; m0 += RT * NGW) {
        f32x4 v[RT][4]; int mm[RT];
#pragma unroll
        for (int t = 0; t < RT; ++t) { const int mq = m0 + t * NGW; mm[t] = mq; const int m = mq < T ? mq : m0;
            const int b = m / LTOK, pos = m - b * LTOK, mr = pos < CTX ? 8 : b;
            if (l == 0) { const float* src = pos < CTX ? GIN(F.in, I_CTX) + (size_t)(b * CTX + pos) * D : GIN(F.in, I_X) + (size_t)(b * SEQ + pos - CTX) * D;
#pragma unroll
                for (int j = 0; j < 4; ++j) v[t][j] = *(const f32x4*)(src + 4 * lane + 256 * j);
            } else if (mq < T) {
                bf16_t* xr = WSP(bf16_t, WS_XRES) + (size_t)m * D; f32x4 cv[4]; moe_comb_row(F, 0, m, cv);
                const float* m5 = WSP(float, WS_MOD) + (size_t)mr * 6144 + 5 * D;
#pragma unroll
                for (int j = 0; j < 4; ++j) { const int col = 4 * lane + 256 * j; v[t][j] = unpack4(*(const u32x2*)(xr + col)) + *(const f32x4*)(m5 + col) * cv[j]; *(u32x2*)(xr + col) = pack4(v[t][j]); }
            } else {
#pragma unroll
                for (int j = 0; j < 4; ++j) v[t][j] = (f32x4){0.f, 0.f, 0.f, 0.f}; }
            float ss = 0.f;
#pragma unroll
            for (int j = 0; j < 4; ++j) ss += v[t][j][0] * v[t][j][0] + v[t][j][1] * v[t][j][1] + v[t][j][2] * v[t][j][2] + v[t][j][3] * v[t][j][3];
            const float rstd = rsqrtf(wave_sum(ss) * (1.f / D) + EPS);
            bf16_t* o = WSP(bf16_t, WS_HZ) + (size_t)m * D; unsigned char* o8 = F.ws + WS_HZ8 + (size_t)m * D;
#pragma unroll
            for (int j = 0; j < 4; ++j) { const int col = 4 * lane + 256 * j; const f32x4 g = *(const f32x4*)(gain + col), sh = *(const f32x4*)(mod + (size_t)mr * 6144 + col), sc = *(const f32x4*)(mod + (size_t)mr * 6144 + D + col);
                v[t][j] = v[t][j] * rstd * g * (sc + 1.f) + sh;
                if (mq < T) { u32x2 w; w.x = pk2(v[t][j][0], v[t][j][1]); w.y = pk2(v[t][j][2], v[t][j][3]); *(u32x2*)(o + col) = w; *(unsigned*)(o8 + col) = pk4_fp8(v[t][j][0], v[t][j][1], v[t][j][2], v[t][j][3]); } } }
        float abv[RT];
#pragma unroll
        for (int t = 0; t < RT; ++t) abv[t] = 0.f;
#pragma unroll 1
        for (int g = 0; g < 2; ++g) {
            float ab[RT][8];
#pragma unroll
            for (int c = 0; c < 8; ++c) { f32x4 w[4];
#pragma unroll
                for (int j = 0; j < 4; ++j) w[j] = *(const LAS f32x4*)(wab + (g * 8 + c) * D + 4 * lane + 256 * j);
#pragma unroll
                for (int t = 0; t < RT; ++t) { float a = 0.f;
#pragma unroll
                    for (int j = 0; j < 4; ++j) a += v[t][j][0] * w[j][0] + v[t][j][1] * w[j][1] + v[t][j][2] * w[j][2] + v[t][j][3] * w[j][3];
                    ab[t][c] = a; } }
#pragma unroll
            for (int t = 0; t < RT; ++t) {
#pragma unroll
                for (int c = 0; c < 8; ++c) ab[t][c] += xshfl<32>(ab[t][c]);
                { const bool hi = (lane >> 4) & 1;
#pragma unroll
                    for (int e = 0; e < 4; ++e) { const float snd = hi ? ab[t][e] : ab[t][e + 4], kp = hi ? ab[t][e + 4] : ab[t][e]; ab[t][e] = kp + xshfl<16>(snd); } }
                { const bool hi = (lane >> 3) & 1;
#pragma unroll
                    for (int e = 0; e < 2; ++e) { const float snd = hi ? ab[t][e] : ab[t][e + 2], kp = hi ? ab[t][e + 2] : ab[t][e]; ab[t][e] = kp + xshfl<8>(snd); } }
                { const bool hi = (lane >> 2) & 1; const float snd = hi ? ab[t][0] : ab[t][1], kp = hi ? ab[t][1] : ab[t][0]; ab[t][0] = kp + xshfl<4>(snd); }
                ab[t][0] += xshfl<2>(ab[t][0]); ab[t][0] += xshfl<1>(ab[t][0]);
                if ((lane & 1) == g) abv[t] = ab[t][0]; }
        }
#pragma unroll
        for (int t = 0; t < RT; ++t)
            if (mm[t] < T && lane < 32 && (lane & 2) == 0) WSP(float, WS_AB)[(size_t)mm[t] * 16 + 8 * (lane & 1) + 4 * ((lane >> 4) & 1) + 2 * ((lane >> 3) & 1) + ((lane >> 2) & 1)] = abv[t];
    }
}

DI int scan_pos(int s, int dir) { return dir == 0 ? s : (s < CTX ? CTX - 1 - s : LTOK - 1 - (s - CTX)); }
typedef float f32x16 __attribute__((ext_vector_type(16)));
typedef short s16x4 __attribute__((ext_vector_type(4)));
DI int swz16(int row) { return ((row & 3) << 2) | ((row >> 2) & 3); }
DI void glds16(const void* g, LAS void* l) { __builtin_amdgcn_global_load_lds((const unsigned*)g, (LAS unsigned*)l, 16, 0, 0); }
DI s16x4 tr_read(const LAS unsigned char* p) { return __builtin_amdgcn_ds_read_tr16_b64_v4i16((LAS s16x4*)p); }
struct NoMask { DI void apply(f32x16&, int, int) const {} };
struct NaMask {
    const LAS float* tb; int c0; bool on;
    DI void apply(f32x16& S, int sub, int h) const {
        if (!on) return;
#pragma unroll
        for (int i = 0; i < 16; ++i) { const int kc = sub * 32 + (i & 3) + 8 * (i >> 2) + 4 * h; const float bias = tb[kc]; S[i] = ((unsigned)(kc - c0) < 16u) ? S[i] + bias : -INFINITY; }
    }
};
template <int DVB> struct AttnAddr { int k[4]; int v[2][DVB]; };
template <int DVB> DI void attn_addr(AttnAddr<DVB>& A, const int kch, const int vch, const int lane) {
    const int r = lane & 31, h = lane >> 5, q = (lane & 15) >> 2, p = lane & 3, blk = (lane >> 4) & 1;
#pragma unroll
    for (int s = 0; s < 4; ++s) A.k[s] = r * 256 + (((kch + 2 * s + h) ^ swz16(r)) << 4);
#pragma unroll
    for (int hi = 0; hi < 2; ++hi) { const int row = 8 * hi + 4 * h + q;
#pragma unroll
        for (int d = 0; d < DVB; ++d) A.v[hi][d] = row * 256 + (((vch + 4 * d + 2 * blk + (p >> 1)) ^ swz16(row)) << 4) + (p & 1) * 8; }
}
DI float xhalf_max(float v) {
    const auto r2 = __builtin_amdgcn_permlane32_swap(__float_as_uint(v), __float_as_uint(v), false, false);
    return fmaxf(__uint_as_float(r2[0]), __uint_as_float(r2[1]));
}
template <int DVB, class Mask>
DI void attn_tile(const LAS unsigned char* kt, const LAS unsigned char* vt, const AttnAddr<DVB>& A, const bf16x8 (&qf)[4], f32x16 (&O)[DVB], float& m, float& l, const Mask& mk, const int lane) {
    const int h = lane >> 5;
    f32x16 S[2];
#pragma unroll
    for (int sub = 0; sub < 2; ++sub) {
#pragma unroll
        for (int i = 0; i < 16; ++i) S[sub][i] = 0.f;
#pragma unroll
        for (int s = 0; s < 4; ++s) { const bf16x8 a = *(const LAS bf16x8*)(kt + A.k[s] + sub * 8192); S[sub] = __builtin_amdgcn_mfma_f32_32x32x16_bf16(a, qf[s], S[sub], 0, 0, 0); }
    }
    mk.apply(S[0], 0, h); mk.apply(S[1], 1, h);
    float tm = fmaxf(S[0][0], S[1][0]);
#pragma unroll
    for (int i = 1; i < 16; ++i) tm = fmaxf(tm, fmaxf(S[0][i], S[1][i]));
    tm = xhalf_max(tm);
    const float mn = fmaxf(m, tm);
    float ps = 0.f;
#pragma unroll
    for (int sub = 0; sub < 2; ++sub)
#pragma unroll
        for (int i = 0; i < 16; ++i) { S[sub][i] = __builtin_amdgcn_exp2f(S[sub][i] - mn); ps += S[sub][i]; }
    if (__builtin_amdgcn_ballot_w64(mn != m) != 0ull) {
        const float corr = __builtin_amdgcn_exp2f(m - mn); m = mn; l *= corr;
#pragma unroll
        for (int d = 0; d < DVB; ++d)
#pragma unroll
            for (int i = 0; i < 16; ++i) O[d][i] *= corr; }
    l += ps;
    bf16x8 pf[4];
#pragma unroll
    for (int s4 = 0; s4 < 4; ++s4) { const int sub = s4 >> 1, o = 8 * (s4 & 1); u32x4 w; w.x = cvt_pk_bf16(S[sub][o], S[sub][o + 1]); w.y = cvt_pk_bf16(S[sub][o + 2], S[sub][o + 3]); w.z = cvt_pk_bf16(S[sub][o + 4], S[sub][o + 5]); w.w = cvt_pk_bf16(S[sub][o + 6], S[sub][o + 7]);
        pf[s4] = __builtin_bit_cast(bf16x8, w); }
#pragma unroll
    for (int s4 = 0; s4 < 4; ++s4) {
#pragma unroll
        for (int d = 0; d < DVB; ++d) {
            const s16x4 lo = tr_read(vt + A.v[0][d] + s4 * 4096), hi = tr_read(vt + A.v[1][d] + s4 * 4096);
            O[d] = __builtin_amdgcn_mfma_f32_32x32x16_bf16(__builtin_shufflevector(lo, hi, 0, 1, 2, 3, 4, 5, 6, 7), pf[s4], O[d], 0, 0, 0); }
    }
}
DI void diff_item(const Ctx& F, int l, int b, int h, int q0, int nkeys) {
    const int lane = F.lane, comp = F.wave & 1, qsub = F.wave >> 1, r = lane & 31, hh = lane >> 5;
    const bf16_t* Pb = WSP(bf16_t, WS_P) + (size_t)b * LTOK * PW;
    bf16x8 qf[4];
    { const bf16_t* qp = Pb + (size_t)(q0 + qsub * 32 + r) * PW + C_DFQ + h * 128 + comp * 64 + 8 * hh;
#pragma unroll
        for (int s = 0; s < 4; ++s) qf[s] = *(const bf16x8*)(qp + 16 * s); }
    f32x16 O[4];
#pragma unroll
    for (int d = 0; d < 4; ++d)
#pragma unroll
        for (int i = 0; i < 16; ++i) O[d][i] = 0.f;
    float m = -1e30f, lsum = 0.f;
    AttnAddr<4> AD; attn_addr<4>(AD, comp * 8, 0, lane);
    const int nt = nkeys / 64;
    auto stage = [&](int t) {
        LAS unsigned char* kt = F.lds + (t & 1) * 16384; LAS unsigned char* vt = F.lds + 32768 + (t & 1) * 16384;
#pragma unroll
        for (int i = 0; i < 2; ++i) { const int pp = F.tid + 512 * i, row = pp >> 4, c = (pp & 15) ^ swz16(row);
            const bf16_t* src = Pb + (size_t)(t * 64 + row) * PW + h * 128 + c * 8;
            glds16(src + C_DFK, kt + (F.wave * 64 + 512 * i) * 16); glds16(src + C_DFV, vt + (F.wave * 64 + 512 * i) * 16); } };
    stage(0);
    for (int t = 0; t < nt; ++t) {
        asm volatile("s_waitcnt vmcnt(0)" ::: "memory"); __syncthreads();
        if (t + 1 < nt) stage(t + 1);
        attn_tile<4>(F.lds + (t & 1) * 16384, F.lds + 32768 + (t & 1) * 16384, AD, qf, O, m, lsum, NoMask{}, lane);
    }
    const float lt = lsum + xshfl<32>(lsum), inv = 1.f / lt;
    __syncthreads();
    LAS float* ex = (LAS float*)F.lds + qsub * 4096;
    if (comp == 1) {
#pragma unroll
        for (int d = 0; d < 4; ++d)
#pragma unroll
            for (int i = 0; i < 16; ++i) ex[(d * 16 + i) * 64 + lane] = O[d][i] * inv; }
    __syncthreads();
    if (comp == 0) {
        const float* lp = GIN(F.in, I_DFLAM) + (size_t)l * 4 * 64;
        float s01 = lp[lane] * lp[64 + lane], s23 = lp[128 + lane] * lp[192 + lane]; s01 = wave_sum(s01); s23 = wave_sum(s23);
        const float lam_init = 0.8f - 0.6f * __expf(-0.3f * (float)l), lam = __expf(s01) - __expf(s23) + lam_init;
        float ss = 0.f;
#pragma unroll
        for (int d = 0; d < 4; ++d)
#pragma unroll
            for (int i = 0; i < 16; ++i) { const float v = O[d][i] * inv - lam * ex[(d * 16 + i) * 64 + lane]; O[d][i] = v; ss += v * v; }
        ss += xshfl<32>(ss);
        const float rn = rsqrtf(ss * (1.f / 128.f) + EPS) * (1.f - lam_init);
        const float* sg = GIN(F.in, I_DFSUB) + (size_t)l * 128;
        bf16_t* yp = WSP(bf16_t, WS_YS) + (size_t)(b * LTOK + q0 + qsub * 32 + r) * YSW + 1024 + h * 128;
#pragma unroll
        for (int d = 0; d < 4; ++d)
#pragma unroll
            for (int g = 0; g < 4; ++g) { const int dv = d * 32 + 8 * g + 4 * hh; const f32x4 gg = *(const f32x4*)(sg + dv);
                u32x2 w; w.x = pk2(O[d][4 * g] * rn * gg[0], O[d][4 * g + 1] * rn * gg[1]); w.y = pk2(O[d][4 * g + 2] * rn * gg[2], O[d][4 * g + 3] * rn * gg[3]); *(u32x2*)(yp + dv) = w; }
    }
    __syncthreads();
}
DI void na_item(const Ctx& F, int l, int b, int h, int g, bool ctxq) {
    const int lane = F.lane, rr = F.wave >> 1, qh = F.wave & 1, r = lane & 31, hh = lane >> 5;
    const bf16_t* Pb = WSP(bf16_t, WS_P) + (size_t)b * LTOK * PW;
    LAS float* tbl = (LAS float*)(F.lds + 65536 + 1024);
    if (!ctxq) { for (int i = F.tid; i < 15 * 31; i += 512) tbl[i] = GIN(F.in, I_NARPB)[((size_t)l * 8 + h) * 465 + i] * 1.4426950408889634f; }
    const int grow = 4 * g + rr, c = qh * 32 + r;
    const int qpos = ctxq ? F.wave * 32 + r : CTX + grow * 64 + c;
    bf16x8 qf[4];
    { const bf16_t* qp = Pb + (size_t)qpos * PW + C_NAQ + h * 64 + 8 * hh;
#pragma unroll
        for (int s = 0; s < 4; ++s) qf[s] = *(const bf16x8*)(qp + 16 * s); }
    f32x16 O[2];
#pragma unroll
    for (int d = 0; d < 2; ++d)
#pragma unroll
        for (int i = 0; i < 16; ++i) O[d][i] = 0.f;
    float m = -1e30f, lsum = 0.f;
    AttnAddr<2> AD; attn_addr<2>(AD, 0, 8, lane);
    const int kr_lo = ctxq ? 0 : min(max(4 * g - 4, 0), GRID_R - 8), kr_hi = ctxq ? -1 : min(max(4 * g - 1, 0), GRID_R - 8) + 7;
    const int ngrid = kr_hi - kr_lo + 1, nt = ngrid + 4;
    const int r0 = min(max(grow - 4, 0), GRID_R - 8), c0 = min(max(c - 8, 0), GRID_W - 16);
    auto stage = [&](int t) {
        LAS unsigned char* kt = F.lds + (t & 1) * 16384;
        const int krow0 = t < ngrid ? CTX + (kr_lo + t) * 64 : (t - ngrid) * 64;
#pragma unroll
        for (int i = 0; i < 2; ++i) { const int pp = F.tid + 512 * i, row = pp >> 4, cc = (pp & 15) ^ swz16(row);
            const bf16_t* src = Pb + (size_t)(krow0 + row) * PW + h * 64 + (cc < 8 ? C_NAK + cc * 8 : C_NAV + (cc - 8) * 8);
            glds16(src, kt + (F.wave * 64 + 512 * i) * 16); } };
    stage(0);
    for (int t = 0; t < nt; ++t) {
        asm volatile("s_waitcnt vmcnt(0)" ::: "memory"); __syncthreads();
        if (t + 1 < nt) stage(t + 1);
        const LAS unsigned char* kt = F.lds + (t & 1) * 16384;
        if (t < ngrid) { const int kr = kr_lo + t;
            if (kr >= r0 && kr < r0 + 8) { NaMask mk{tbl + (kr - grow + 7) * 31 + 15 - c, c0, true}; attn_tile<2>(kt, kt, AD, qf, O, m, lsum, mk, lane); } }
        else attn_tile<2>(kt, kt, AD, qf, O, m, lsum, NoMask{}, lane);
    }
    const float lt = lsum + xshfl<32>(lsum), inv = 1.f / lt;
    bf16_t* yp = WSP(bf16_t, WS_YS) + (size_t)(b * LTOK + qpos) * YSW + h * 64;
#pragma unroll
    for (int d = 0; d < 2; ++d)
#pragma unroll
        for (int gq = 0; gq < 4; ++gq) { const int dv = d * 32 + 8 * gq + 4 * hh;
            u32x2 w; w.x = pk2(O[d][4 * gq] * inv, O[d][4 * gq + 1] * inv); w.y = pk2(O[d][4 * gq + 2] * inv, O[d][4 * gq + 3] * inv); *(u32x2*)(yp + dv) = w; }
    __syncthreads();
}
DI int tpos(int row, int ch) { return row * 256 + ((ch ^ swz16(row)) << 4); }
DI float wave_incl_scan(float v, int lane) {
#pragma unroll
    for (int o = 1; o < 64; o <<= 1) { const float t = __shfl_up(v, o); if (lane >= o) v += t; }
    return v;
}
DI int ppos(int row, int ch) { return row * 272 + ch * 16; }
struct PrepRaw { u32x4 r[2][10]; };
DI void prep_fetch(const Ctx& F, int it, PrepRaw& R) {
    int lane_; asm volatile("v_mbcnt_lo_u32_b32 %0, -1, 0\n\tv_mbcnt_hi_u32_b32 %0, -1, %0" : "=v"(lane_)); const int lane = lane_;
    const int NH = NBATCH * 4 * NCHUNK; const int br = it < NH ? 1 : 0; int x = it < NH ? it : it - NH; const int tc = x % NCHUNK; x /= NCHUNK; const int hd = x & 3, b = x >> 2;
    const bf16_t* Pw = WSP(bf16_t, WS_P);
#pragma unroll
    for (int i = 0; i < 2; ++i) { const int pp = F.wave * 64 + lane + 512 * i, row = pp >> 4, ch = pp & 15; const int pos = tc * 64 + row, m = b * LTOK + pos;
        const bool lat = pos >= CTX; const int li = pos - CTX;
        if (br == 0) {
            const bf16_t* prow = Pw + (size_t)m * PW; const int cq = ch & 7, base = ch < 8 ? C_RK + hd * 64 : C_RQ + hd * 64;
            R.r[i][0] = *(const u32x4*)(prow + base + cq * 8); R.r[i][1] = *(const u32x4*)(prow + base + (cq ^ 4) * 8); R.r[i][2] = *(const u32x4*)(prow + C_RV + hd * 128 + ch * 8);
#pragma unroll
            for (int k = 3; k < 10; ++k) R.r[i][k] = R.r[i][0];
        } else {
            const int segpos = lat ? li : pos, seglen = lat ? SEQ : CTX;
            const int chq = ch < 8 ? 256 + hd * 64 + ch * 8 : hd * 64 + (ch - 8) * 8, chv = 512 + hd * 128 + ch * 8;
#pragma unroll
            for (int tp = 0; tp < 5; ++tp) { const int sp = segpos + tp - 2; const bool ok = sp >= 0 && sp < seglen;
                const bf16_t* prow = Pw + (size_t)(ok ? m + tp - 2 : m) * PW + C_DNQ; R.r[i][2 * tp] = *(const u32x4*)(prow + chq); R.r[i][2 * tp + 1] = *(const u32x4*)(prow + chv); }
        } }
}
DI void prep_chunk(const Ctx& F, int l, int it, bool valid, LAS unsigned char* gl, LAS float* sm  , PrepRaw& R, int itn) {
    int lane_ = F.lane; asm volatile("" : "+v"(lane_));
    const int lane = lane_, gw = F.wave & 3, gt = (F.wave & 3) * 64 + lane, r = lane & 31, h = lane >> 5, q = (lane & 15) >> 2, p = lane & 3, blk = (lane >> 4) & 1;
    const int NH = NBATCH * 4 * NCHUNK; const int br = it < NH ? 1 : 0; int x = it < NH ? it : it - NH; const int tc = x % NCHUNK; x /= NCHUNK; const int hd = x & 3, b = x >> 2, dir = F.wave >> 2;
    const int c = dir == 0 ? tc : (tc < 4 ? 3 - tc : 39 - tc);
    const int seq = ((br * 8 + b) * 4 + hd) * 2 + dir, ci = seq * NCHUNK + c;
    LAS unsigned char* KQ = gl; LAS unsigned char* VT = gl + 17408; LAS float* Lm = (LAS float*)(gl + 34816); LAS unsigned char* TT = gl + 51200;
    unsigned char* img = F.ws + WS_SEQT + (size_t)ci * 32768; bf16_t* UT = (bf16_t*)(F.ws + WS_SEQU + (size_t)ci * 16384);
    const bf16_t* Pw = WSP(bf16_t, WS_P);
#pragma unroll
    for (int i = 0; i < 2; ++i) { const int pp = F.wave * 64 + lane + 512 * i, row = pp >> 4, ch = pp & 15; const int pos = tc * 64 + row, m = b * LTOK + pos;
        const bool lat = pos >= CTX; const int li = pos - CTX;
        float kq[8], vv[8];
        if (br == 0) {
            const bf16_t* prow = Pw + (size_t)m * PW; const int cq = ch & 7, base = ch < 8 ? C_RK + hd * 64 : C_RQ + hd * 64;
            unpack8(R.r[i][0], kq);
            { float pr[8]; unpack8(R.r[i][1], pr); const bool x1 = cq < 4; const float* ct = WSP(float, WS_ROPE) + (lat ? li : 0) * 32 + (cq & 3) * 8; const float* st = ct + 2048 * 32;
#pragma unroll
                for (int j = 0; j < 8; ++j) { const float cs = lat ? ct[j] : 1.f, sn = lat ? st[j] : 0.f; kq[j] = x1 ? kq[j] * cs - pr[j] * sn : kq[j] * cs + pr[j] * sn; } }
            if (ch < 8) {
#pragma unroll
                for (int j = 0; j < 8; ++j) kq[j] *= 0.125f; }
            unpack8(R.r[i][2], vv);
        } else {
            const int segpos = lat ? li : pos, seglen = lat ? SEQ : CTX;
            const int chq = ch < 8 ? 256 + hd * 64 + ch * 8 : hd * 64 + (ch - 8) * 8, chv = 512 + hd * 128 + ch * 8;
            const float* cw = GIN(F.in, I_DNCONV) + (size_t)l * 5 * 1024;
#pragma unroll
            for (int j = 0; j < 8; ++j) { kq[j] = 0.f; vv[j] = 0.f; }
#pragma unroll
            for (int tp = 0; tp < 5; ++tp) { const int sp = segpos + tp - 2; const bool ok = sp >= 0 && sp < seglen; const float zf = ok ? 1.f : 0.f;
                float x[8], y[8]; unpack8(R.r[i][2 * tp], x); unpack8(R.r[i][2 * tp + 1], y);
                const f32x4 a0 = *(const f32x4*)(cw + tp * 1024 + chq) * zf, a1 = *(const f32x4*)(cw + tp * 1024 + chq + 4) * zf, b0 = *(const f32x4*)(cw + tp * 1024 + chv) * zf, b1 = *(const f32x4*)(cw + tp * 1024 + chv + 4) * zf;
#pragma unroll
                for (int j = 0; j < 4; ++j) { kq[j] += x[j] * a0[j]; kq[4 + j] += x[4 + j] * a1[j]; vv[j] += y[j] * b0[j]; vv[4 + j] += y[4 + j] * b1[j]; } }
            float ss = 0.f;
#pragma unroll
            for (int j = 0; j < 8; ++j) { kq[j] = siluf_(kq[j]); vv[j] = siluf_(vv[j]); ss += kq[j] * kq[j]; }
            ss += xshfl<1>(ss); ss += xshfl<2>(ss); ss += xshfl<4>(ss);
            const float rn = rsqrtf(ss + EPS) * (ch < 8 ? 1.f : 0.125f);
#pragma unroll
            for (int j = 0; j < 8; ++j) kq[j] *= rn;
        }
        const u32x4 wk = pack8(kq), wv = pack8(vv);
        *(LAS u32x4*)(F.lds + ppos(row, ch)) = wk; *(LAS u32x4*)(F.lds + 17408 + ppos(row, ch)) = wv;
        *(LAS u32x4*)(F.lds + 69632 + ppos(63 - row, ch)) = wk; *(LAS u32x4*)(F.lds + 69632 + 17408 + ppos(63 - row, ch)) = wv; }
    if (gw == 0) { const int m = b * LTOK + scan_pos(c * 64 + lane, dir); float g, be;
        if (br == 0) { g = __logf(sigmoidf_(GIN(F.in, I_RETDEC)[(l * 2 + dir) * 4 + hd])); be = 1.f; }
        else { const float av = WSP(float, WS_AB)[(size_t)m * 16 + dir * 4 + hd], bv = WSP(float, WS_AB)[(size_t)m * 16 + 8 + dir * 4 + hd];
            const float xx = av + GIN(F.in, I_DNDT)[l * 8 + dir * 4 + hd]; const float sp = xx > 20.f ? xx : log1pf(__expf(xx));
            g = -__expf(GIN(F.in, I_DNALOG)[l * 8 + dir * 4 + hd]) * sp; be = sigmoidf_(bv); }
        const float gc = wave_incl_scan(g, lane); sm[lane] = gc; sm[64 + lane] = be;
        if (lane == 63 && valid) WSP(float, WS_SEQG)[ci] = __expf(gc); }
    __syncthreads();
    const int rl = (gw + 2 * (F.wave >> 2)) & 3;
    if (rl < 3) {
        const int jb = rl == 2 ? 1 : 0, ib = rl == 0 ? 0 : 1;
        f32x16 aq, ak;
#pragma unroll
        for (int i = 0; i < 16; ++i) { aq[i] = 0.f; ak[i] = 0.f; }
#pragma unroll
        for (int s = 0; s < 4; ++s) { const bf16x8 a = *(const LAS bf16x8*)(KQ + ppos(jb * 32 + r, 2 * s + h));
            const bf16x8 bq = *(const LAS bf16x8*)(KQ + ppos(ib * 32 + r, 8 + 2 * s + h)); aq = __builtin_amdgcn_mfma_f32_32x32x16_bf16(a, bq, aq, 0, 0, 0);
            if (br == 1) { const bf16x8 bk = *(const LAS bf16x8*)(KQ + ppos(ib * 32 + r, 2 * s + h)); ak = __builtin_amdgcn_mfma_f32_32x32x16_bf16(a, bk, ak, 0, 0, 0); } }
        const int irow = ib * 32 + r; const float gci = sm[irow], bi = sm[64 + irow];
#pragma unroll
        for (int g = 0; g < 4; ++g) { const int j0 = jb * 32 + 8 * g + 4 * h; float qv[4], lv[4];
#pragma unroll
            for (int jj = 0; jj < 4; ++jj) { const int j = j0 + jj; const float dec = __expf(gci - sm[j]); qv[jj] = j <= irow ? aq[4 * g + jj] * dec : 0.f; lv[jj] = j < irow ? ak[4 * g + jj] * dec * bi : 0.f; }
            if (valid) { u32x2 w; w.x = pk2(qv[0], qv[1]); w.y = pk2(qv[2], qv[3]); *(u32x2*)(img + 16384 + tpos(irow, j0 >> 3) + (j0 & 7) * 2) = w; }
            if (br == 1) *(LAS f32x4*)(Lm + irow * 64 + j0) = (f32x4){lv[0], lv[1], lv[2], lv[3]}; }
    } else {
        const float gcl = sm[63];
#pragma unroll
        for (int i = 0; i < 16; ++i) { const int pp = lane + 64 * i, row = pp >> 4, ch = pp & 15;
            float f[8]; unpack8(*(const LAS u32x4*)(KQ + ppos(row, ch)), f); const float sc = ch < 8 ? __expf(gcl - sm[row]) : __expf(sm[row]);
#pragma unroll
            for (int j = 0; j < 8; ++j) f[j] *= sc;
            if (valid) *(u32x4*)(img + (ch < 8 ? 16384 + tpos(row, 8 + ch) : tpos(row, ch))) = pack8(f); }
    }
    if (br == 0) {
#pragma unroll
        for (int n = 0; n < 8; ++n) { const s16x4 t = tr_read(VT + ppos(8 * n + 4 * h + q, 4 * gw + 2 * blk + (p >> 1)) + (p & 1) * 8);
            if (valid) *(s16x4*)(UT + (size_t)(gw * 32 + r) * 64 + 8 * n + 4 * h) = t; }
    }
    __syncthreads();
    if (br == 1) {
        if (rl < 2) {
            const int o = 32 * rl, c = lane & 31;
            float t[32];
#pragma unroll
            for (int g = 0; g < 8; ++g) {
                f32x4 lv[4][8];
#pragma unroll
                for (int r4 = 0; r4 < 4; ++r4)
#pragma unroll
                    for (int q4 = 0; q4 <= g; ++q4) lv[r4][q4] = *(const LAS f32x4*)(Lm + (o + 4 * g + r4) * 64 + o + 4 * q4);
#pragma unroll
                for (int r4 = 0; r4 < 4; ++r4) { const int i = 4 * g + r4; float a4[4] = {(i == c) ? 1.f : 0.f, 0.f, 0.f, 0.f};
#pragma unroll
                    for (int q4 = 0; q4 <= g; ++q4)
#pragma unroll
                        for (int jj = 0; jj < 4; ++jj) if (4 * q4 + jj < i) a4[jj] -= lv[r4][q4][jj] * t[4 * q4 + jj];
                    t[i] = (a4[0] + a4[1]) + (a4[2] + a4[3]); } }
            const float be = sm[64 + o + c], beg = be * __expf(sm[o + c]);
            if (lane < 32) {
#pragma unroll
                for (int i = 0; i < 32; ++i) { *(LAS bf16_t*)(TT + (o + i) * 272 + (o + c) * 2) = (bf16_t)f2bf(t[i] * be); *(LAS bf16_t*)(TT + (o + i) * 272 + 128 + (o + c) * 2) = (bf16_t)f2bf(t[i] * beg);
                    *(LAS bf16_t*)(KQ + (o + i) * 272 + 128 + c * 2) = (bf16_t)f2bf(t[i]); }
            } else if (rl == 0) {
#pragma unroll
                for (int i = 0; i < 32; ++i) { *(LAS bf16_t*)(TT + i * 272 + (32 + c) * 2) = 0; *(LAS bf16_t*)(TT + i * 272 + 128 + (32 + c) * 2) = 0; }
            }
        } else if (rl == 3) {
#pragma unroll
            for (int k2 = 0; k2 < 2; ++k2) { const int task = lane + 64 * k2, ip = task >> 2, j0 = (task & 3) * 8;
                const f32x4 x0 = *(const LAS f32x4*)(Lm + (32 + ip) * 64 + j0), x1 = *(const LAS f32x4*)(Lm + (32 + ip) * 64 + j0 + 4);
                u32x4 w; w.x = pk2(x0[0], x0[1]); w.y = pk2(x0[2], x0[3]); w.z = pk2(x1[0], x1[1]); w.w = pk2(x1[2], x1[3]);
                *(LAS u32x4*)(KQ + ip * 272 + 192 + j0 * 2) = w; }
        }
        __syncthreads();
        if (rl == 2) {
            f32x16 m1, m2;
#pragma unroll
            for (int i = 0; i < 16; ++i) { m1[i] = 0.f; m2[i] = 0.f; }
#pragma unroll
            for (int s2 = 0; s2 < 2; ++s2) {
                const bf16x8 a = *(const LAS bf16x8*)(KQ + r * 272 + 192 + (2 * s2 + h) * 16);
                const int ch = 8 + 2 * blk + (p >> 1);
                const s16x4 lo = tr_read(KQ + ppos(16 * s2 + 8 * h + q, ch) + (p & 1) * 8), hi = tr_read(KQ + ppos(16 * s2 + 8 * h + 4 + q, ch) + (p & 1) * 8);
                m1 = __builtin_amdgcn_mfma_f32_32x32x16_bf16(a, __builtin_shufflevector(lo, hi, 0, 1, 2, 3, 4, 5, 6, 7), m1, 0, 0, 0); }
#pragma unroll
            for (int s2 = 0; s2 < 2; ++s2) {
                u32x4 w; w.x = cvt_pk_bf16(m1[8 * s2], m1[8 * s2 + 1]); w.y = cvt_pk_bf16(m1[8 * s2 + 2], m1[8 * s2 + 3]); w.z = cvt_pk_bf16(m1[8 * s2 + 4], m1[8 * s2 + 5]); w.w = cvt_pk_bf16(m1[8 * s2 + 6], m1[8 * s2 + 7]);
                const s16x4 lo = *(const LAS s16x4*)(KQ + (32 + r) * 272 + 128 + (2 * s2) * 16 + 8 * h), hi = *(const LAS s16x4*)(KQ + (32 + r) * 272 + 128 + (2 * s2 + 1) * 16 + 8 * h);
                m2 = __builtin_amdgcn_mfma_f32_32x32x16_bf16(__builtin_shufflevector(lo, hi, 0, 1, 2, 3, 4, 5, 6, 7), __builtin_bit_cast(bf16x8, w), m2, 0, 0, 0); }
            const float be = sm[64 + r], beg = be * __expf(sm[r]);
#pragma unroll
            for (int i = 0; i < 16; ++i) { const int row = 32 + (i & 3) + 8 * (i >> 2) + 4 * h;
                *(LAS bf16_t*)(TT + row * 272 + r * 2) = (bf16_t)f2bf(-m2[i] * be); *(LAS bf16_t*)(TT + row * 272 + 128 + r * 2) = (bf16_t)f2bf(-m2[i] * beg); }
        }
        __syncthreads();
        prep_fetch(F, itn, R);
        { f32x16 u[2];
#pragma unroll
            for (int ib = 0; ib < 2; ++ib)
#pragma unroll
                for (int i = 0; i < 16; ++i) u[ib][i] = 0.f;
#pragma unroll
            for (int s = 0; s < 4; ++s) { const int ch = 4 * gw + 2 * blk + (p >> 1);
                const s16x4 lo = tr_read(VT + ppos(16 * s + 8 * h + q, ch) + (p & 1) * 8), hi = tr_read(VT + ppos(16 * s + 8 * h + 4 + q, ch) + (p & 1) * 8);
                const bf16x8 bv = __builtin_shufflevector(lo, hi, 0, 1, 2, 3, 4, 5, 6, 7);
#pragma unroll
                for (int ib = 0; ib < 2; ++ib) { if (ib == 0 && s >= 2) continue; const bf16x8 a = *(const LAS bf16x8*)(TT + ppos(ib * 32 + r, 2 * s + h)); u[ib] = __builtin_amdgcn_mfma_f32_32x32x16_bf16(a, bv, u[ib], 0, 0, 0); } }
            if (valid) {
#pragma unroll
                for (int ib = 0; ib < 2; ++ib)
#pragma unroll
                    for (int g = 0; g < 4; ++g) { u32x2 w; w.x = pk2(u[ib][4 * g], u[ib][4 * g + 1]); w.y = pk2(u[ib][4 * g + 2], u[ib][4 * g + 3]); *(u32x2*)(UT + (size_t)(gw * 32 + r) * 64 + ib * 32 + 8 * g + 4 * h) = w; } } }
        { const int db = gw & 1, ib = gw >> 1; f32x16 w;
#pragma unroll
            for (int i = 0; i < 16; ++i) w[i] = 0.f;
#pragma unroll
            for (int s = 0; s < 4; ++s) { if (ib == 0 && s >= 2) continue; const int ch = 4 * db + 2 * blk + (p >> 1);
                const s16x4 lo = tr_read(KQ + ppos(16 * s + 8 * h + q, ch) + (p & 1) * 8), hi = tr_read(KQ + ppos(16 * s + 8 * h + 4 + q, ch) + (p & 1) * 8);
                const bf16x8 a = __builtin_shufflevector(lo, hi, 0, 1, 2, 3, 4, 5, 6, 7);
                const bf16x8 bt = *(const LAS bf16x8*)(TT + ppos(ib * 32 + r, 8 + 2 * s + h)); w = __builtin_amdgcn_mfma_f32_32x32x16_bf16(a, bt, w, 0, 0, 0); }
            if (valid) {
#pragma unroll
                for (int g = 0; g < 4; ++g) { const int d0 = db * 32 + 8 * g + 4 * h; u32x2 o; o.x = pk2(-w[4 * g], -w[4 * g + 1]); o.y = pk2(-w[4 * g + 2], -w[4 * g + 3]);
                    *(u32x2*)(img + tpos(ib * 32 + r, d0 >> 3) + (d0 & 7) * 2) = o; } } }
        __syncthreads();
    } else { prep_fetch(F, itn, R); __syncthreads(); __syncthreads(); __syncthreads(); }
}
DI void phase_seqprep(const Ctx& F, int l) {
    const int grp = F.wave >> 2, N = 2 * NBATCH * 4 * NCHUNK;
    LAS unsigned char* gl = F.lds + grp * 69632; LAS float* sm = (LAS float*)(F.lds + 139264 + grp * 512);
    const int iters = (N + F.G - 1) / F.G;
    PrepRaw R; { int it0 = F.bid < N ? F.bid : N - 1; prep_fetch(F, it0, R); }
    for (int k = 0; k < iters; ++k) { int it = k * F.G + F.bid; const bool valid = it < N; if (!valid) it = N - 1; int itn = (k + 1) * F.G + F.bid; if (itn >= N) itn = N - 1;
        prep_chunk(F, l, it, valid, gl, sm, R, itn); }
}
DI void seq_chunked_item(const Ctx& F, int l, int item, unsigned done_off) {
    const int lane = F.lane, grp = F.wave >> 2, eb = F.wave & 3, gt = F.tid & 255, r = lane & 31, h = lane >> 5, q = (lane & 15) >> 2, p = lane & 3, blk = (lane >> 4) & 1;
    const int seq = item * 2 + grp, dir = seq & 1, hd = (seq >> 1) & 3, b = (seq >> 3) & 7, br = seq >> 6;
    const unsigned char* TG = F.ws + WS_SEQT + (size_t)seq * NCHUNK * 32768; const bf16_t* UG = (const bf16_t*)(F.ws + WS_SEQU + (size_t)seq * NCHUNK * 16384) + (size_t)(eb * 32 + r) * 64 + 4 * h;
    const float* GL = WSP(float, WS_SEQG) + (size_t)seq * NCHUNK;
    LAS unsigned char* gb = F.lds + grp * 65536;
    int aW[4][2], aQ[4][2], aK[2][2];
#pragma unroll
    for (int s = 0; s < 4; ++s)
#pragma unroll
        for (int hi = 0; hi < 2; ++hi) { aW[s][hi] = tpos(r, 2 * s + hi) + 8 * h; aQ[s][hi] = tpos(r, 8 + 2 * s + hi) + 8 * h; }
#pragma unroll
    for (int hi = 0; hi < 2; ++hi)
#pragma unroll
        for (int db = 0; db < 2; ++db) aK[hi][db] = tpos(8 * hi + 4 * h + q, 8 + 4 * db + 2 * blk + (p >> 1)) + (p & 1) * 8;
    auto stage = [&](int c) {
#pragma unroll
        for (int i = 0; i < 8; ++i) glds16(TG + (size_t)c * 32768 + (size_t)(gt + 256 * i) * 16, gb + (c & 1) * 32768 + (eb * 64 + 256 * i) * 16); };
    u32x2 ur[2][4];
    auto loadu = [&](int c) {
#pragma unroll
        for (int ib = 0; ib < 2; ++ib)
#pragma unroll
            for (int g = 0; g < 4; ++g) ur[ib][g] = *(const u32x2*)(UG + (size_t)c * 8192 + ib * 32 + 8 * g); };
    f32x16 S[2];
#pragma unroll
    for (int db = 0; db < 2; ++db)
#pragma unroll
        for (int i = 0; i < 16; ++i) S[db][i] = 0.f;
    bf16_t* oseq = WSP(bf16_t, WS_OSEQ) + ((size_t)(br * 2 + dir) * T) * 512 + hd * 128 + eb * 32 + r;
    stage(0); loadu(0);
    for (int c = 0; c < NCHUNK; ++c) {
        asm volatile("s_waitcnt vmcnt(0)" ::: "memory"); __syncthreads();
        if (c + 1 < NCHUNK) stage(c + 1);
        const LAS unsigned char* t1 = gb + (c & 1) * 32768; const LAS unsigned char* t2 = t1 + 16384;
        f32x16 V2[2], O[2];
#pragma unroll
        for (int ib = 0; ib < 2; ++ib)
#pragma unroll
            for (int g = 0; g < 4; ++g) { V2[ib][4 * g] = __uint_as_float(ur[ib][g].x << 16); V2[ib][4 * g + 1] = __uint_as_float(ur[ib][g].x & 0xffff0000u); V2[ib][4 * g + 2] = __uint_as_float(ur[ib][g].y << 16); V2[ib][4 * g + 3] = __uint_as_float(ur[ib][g].y & 0xffff0000u); }
        if (c + 1 < NCHUNK) loadu(c + 1);
        const float gl = GL[c];
        bf16x8 sb[4];
#pragma unroll
        for (int s = 0; s < 4; ++s) { const int db = s >> 1, o = 8 * (s & 1); u32x4 w; w.x = cvt_pk_bf16(S[db][o], S[db][o + 1]); w.y = cvt_pk_bf16(S[db][o + 2], S[db][o + 3]); w.z = cvt_pk_bf16(S[db][o + 4], S[db][o + 5]); w.w = cvt_pk_bf16(S[db][o + 6], S[db][o + 7]); sb[s] = __builtin_bit_cast(bf16x8, w); }
#pragma unroll
        for (int ib = 0; ib < 2; ++ib) {
#pragma unroll
            for (int i = 0; i < 16; ++i) O[ib][i] = 0.f;
#pragma unroll
            for (int s = 0; s < 4; ++s) {
                if (br == 1) { const s16x4 lo = *(const LAS s16x4*)(t1 + aW[s][0] + ib * 8192), hi = *(const LAS s16x4*)(t1 + aW[s][1] + ib * 8192);
                    V2[ib] = __builtin_amdgcn_mfma_f32_32x32x16_bf16(__builtin_shufflevector(lo, hi, 0, 1, 2, 3, 4, 5, 6, 7), sb[s], V2[ib], 0, 0, 0); }
                const s16x4 lo = *(const LAS s16x4*)(t1 + aQ[s][0] + ib * 8192), hi = *(const LAS s16x4*)(t1 + aQ[s][1] + ib * 8192);
                O[ib] = __builtin_amdgcn_mfma_f32_32x32x16_bf16(__builtin_shufflevector(lo, hi, 0, 1, 2, 3, 4, 5, 6, 7), sb[s], O[ib], 0, 0, 0); } }
        bf16x8 vb[4];
#pragma unroll
        for (int s = 0; s < 4; ++s) { const int jb = s >> 1, o = 8 * (s & 1); u32x4 w; w.x = cvt_pk_bf16(V2[jb][o], V2[jb][o + 1]); w.y = cvt_pk_bf16(V2[jb][o + 2], V2[jb][o + 3]); w.z = cvt_pk_bf16(V2[jb][o + 4], V2[jb][o + 5]); w.w = cvt_pk_bf16(V2[jb][o + 6], V2[jb][o + 7]); vb[s] = __builtin_bit_cast(bf16x8, w); }
#pragma unroll
        for (int ib = 0; ib < 2; ++ib)
#pragma unroll
            for (int s = 0; s < 4; ++s) { if (ib == 0 && s >= 2) continue;
                const s16x4 lo = *(const LAS s16x4*)(t2 + aW[s][0] + ib * 8192), hi = *(const LAS s16x4*)(t2 + aW[s][1] + ib * 8192);
                O[ib] = __builtin_amdgcn_mfma_f32_32x32x16_bf16(__builtin_shufflevector(lo, hi, 0, 1, 2, 3, 4, 5, 6, 7), vb[s], O[ib], 0, 0, 0); }
#pragma unroll
        for (int db = 0; db < 2; ++db) {
#pragma unroll
            for (int i = 0; i < 16; ++i) S[db][i] *= gl;
#pragma unroll
            for (int s = 0; s < 4; ++s) { const s16x4 lo = tr_read(t2 + aK[0][db] + s * 4096), hi = tr_read(t2 + aK[1][db] + s * 4096);
                S[db] = __builtin_amdgcn_mfma_f32_32x32x16_bf16(__builtin_shufflevector(lo, hi, 0, 1, 2, 3, 4, 5, 6, 7), vb[s], S[db], 0, 0, 0); } }
#pragma unroll
        for (int ib = 0; ib < 2; ++ib)
#pragma unroll
            for (int i = 0; i < 16; ++i) { const int row = ib * 32 + (i & 3) + 8 * (i >> 2) + 4 * h; const int m = b * LTOK + scan_pos(c * 64 + row, dir); oseq[(size_t)m * 512] = (bf16_t)f2bf(O[ib][i]); }
    }
    asm volatile("s_waitcnt vmcnt(0)" ::: "memory");
    __syncthreads();
    if (F.tid == 0) { __builtin_amdgcn_fence(__ATOMIC_RELEASE, "agent"); asm volatile("s_waitcnt vmcnt(0)" ::: "memory"); { unsigned o_ = done_off; asm volatile("" : "+s"(o_)); __hip_atomic_fetch_add((int*)(F.ws + o_), 1, __ATOMIC_RELAXED, __HIP_MEMORY_SCOPE_AGENT); } }
    __syncthreads();
}
DI void seqpost_rows(const Ctx& F, int l, int m_lo) {
    const int lane = F.lane;
    const bf16_t* os = WSP(bf16_t, WS_OSEQ);
#pragma unroll 1
    for (int q = 0; q < 4; ++q) {
        const int br = q & 1, m0 = m_lo + F.wave * 8 + (q >> 1) * 4;
        u32x4 ra[4], rb[4], rg[4];
        const float* gn = (br == 0 ? GIN(F.in, I_RETGN) : GIN(F.in, I_DNNORM)) + (size_t)l * 128 + (lane & 15) * 8; const f32x4 gn0 = *(const f32x4*)gn, gn1 = *(const f32x4*)(gn + 4);
#pragma unroll
        for (int r = 0; r < 4; ++r) { const int m = m0 + r;
            ra[r] = *(const u32x4*)(os + ((size_t)(br * 2 + 0) * T + m) * 512 + lane * 8); rb[r] = *(const u32x4*)(os + ((size_t)(br * 2 + 1) * T + m) * 512 + lane * 8);
            rg[r] = *(const u32x4*)(WSP(bf16_t, WS_P) + (size_t)m * PW + (br == 0 ? C_RG : C_DNG) + lane * 8); }
#pragma unroll
        for (int r = 0; r < 4; ++r) { const int m = m0 + r;
            float f[8];
            { float fa[8], fb[8]; unpack8(ra[r], fa); unpack8(rb[r], fb);
#pragma unroll
                for (int i = 0; i < 8; ++i) f[i] = fa[i] + fb[i]; }
            if (br == 0) { float s1 = 0.f;
#pragma unroll
                for (int i = 0; i < 8; ++i) s1 += f[i];
                s1 += xshfl<1>(s1); s1 += xshfl<2>(s1); s1 += xshfl<4>(s1); s1 += xshfl<8>(s1);
                const float mean = s1 * (1.f / 128.f);
#pragma unroll
                for (int i = 0; i < 8; ++i) f[i] -= mean; }
            float ss = 0.f;
#pragma unroll
            for (int i = 0; i < 8; ++i) ss += f[i] * f[i];
            ss += xshfl<1>(ss); ss += xshfl<2>(ss); ss += xshfl<4>(ss); ss += xshfl<8>(ss);
            const float rn = rsqrtf(ss * (1.f / 128.f) + EPS);
            float g[8]; unpack8(rg[r], g);
#pragma unroll
            for (int i = 0; i < 8; ++i) f[i] = f[i] * rn * (i < 4 ? gn0[i & 3] : gn1[i & 3]) * siluf_(g[i]);
            *(u32x4*)(WSP(bf16_t, WS_YS) + (size_t)m * YSW + (br == 0 ? 512 : 1536) + lane * 8) = pack8(f); }
    }
}
DI void phase_mixers(const Ctx& F, int l, int rep = 0) {
    const bool last = (l == DEPTH - 1);
    const int N_SEQ = NSEQ / 2, N_DIFF_L = NBATCH * 4 * 16, N_DIFF_C = last ? 0 : NBATCH * 4 * 2, N_NA_L = NBATCH * 8 * 8, N_NA_C = last ? 0 : NBATCH * 8;
#ifndef MIXMASK
#define MIXMASK 7
#endif
    const unsigned ctr_off = (unsigned)(WS_BAR + 14400) + (l * 4 + rep * 8) * 4, done_off = (unsigned)(WS_BAR + 14400) + (16 + l + rep * 2) * 4;
    volatile LAS int* slot = (volatile LAS int*)(F.lds + LDS_BYTES - 32);
#define NEXT_ITEM(q, var) { __syncthreads(); if (F.tid == 0) { unsigned o_ = ctr_off + 4 * (q); asm volatile("" : "+s"(o_)); slot[0] = atomicAdd((int*)(F.ws + o_), 1); } __syncthreads(); var = slot[0]; }
    if (F.wave >= 4) __builtin_amdgcn_s_setprio(1);
    const int NCD = l == 0 ? CV_NITEM : 0, NCN = 0,        NDT = N_DIFF_L + N_DIFF_C + NCD, NNT = N_NA_L + N_NA_C + NCN;
    int it;
    for (;;) { NEXT_ITEM(0, it) if (it >= N_SEQ) break; if (MIXMASK & 1) seq_chunked_item(F, l, it, done_off); }
    for (;;) { NEXT_ITEM(1, it) if (it >= NDT) break;
        const int c0 = (int)(((long)it * NCD) / NDT), c1 = (int)(((long)(it + 1) * NCD) / NDT);
        if (c1 > c0) { convert_range(F, CV_N0, c0 * CV_ITEM, c0 * CV_ITEM + CV_ITEM, 1, 0); continue; }
        if (MIXMASK & 2) { const int ia = it - c0; const bool cq = ia >= N_DIFF_L; const int j = cq ? ia - N_DIFF_L : ia;
            diff_item(F, l, cq ? j >> 3 : j >> 6, cq ? (j >> 1) & 3 : (j >> 4) & 3, cq ? (j & 1) * 128 : CTX + (j & 15) * 128, cq ? CTX : LTOK); } }
    for (;;) { NEXT_ITEM(2, it) if (it >= NNT) break;
        const int c0 = (int)(((long)it * NCN) / NNT), c1 = (int)(((long)(it + 1) * NCN) / NNT);
        if (c1 > c0) { convert_range(F, CV_N0, (NCD + c0) * CV_ITEM, (NCD + c0) * CV_ITEM + CV_ITEM, 1, 0); continue; }
        if (MIXMASK & 4) { const int ia = it - c0; const bool cq = ia >= N_NA_L; const int j = cq ? ia - N_NA_L : ia; na_item(F, l, cq ? j >> 3 : j >> 6, cq ? j & 7 : (j >> 3) & 7, cq ? 0 : j & 7, cq); } }
    if (F.tid == 0) { unsigned sp = 0; unsigned o_ = done_off; asm volatile("" : "+s"(o_)); const int* done = (const int*)(F.ws + o_); while (__hip_atomic_load(done, __ATOMIC_RELAXED, __HIP_MEMORY_SCOPE_AGENT) < N_SEQ) { __builtin_amdgcn_s_sleep(4); if (++sp > (1u << 22)) break; }
        __builtin_amdgcn_fence(__ATOMIC_ACQUIRE, "agent"); asm volatile("s_waitcnt vmcnt(0)" ::: "memory"); }
    for (;;) { NEXT_ITEM(3, it) if (it >= T / 64) break; seqpost_rows(F, l, it * 64); }
    __builtin_amdgcn_s_setprio(0);
#undef NEXT_ITEM
}
DI void phase_sum4(const Ctx& F, int l) {
    const unsigned char* G = F.ws + WS_P; bf16_t* mx = WSP(bf16_t, WS_MIXED);
    const int nrows = l == DEPTH - 1 ? NBATCH * SEQ : T; const int n = nrows * 64, stride = F.G * 512;
    constexpr int UB = 3;
    for (int i0 = F.bid * 512 + F.tid; i0 < n; i0 += UB * stride) {
        u32x4 w[UB][4]; int rowv[UB], c16v[UB]; bool ok[UB];
#pragma unroll
        for (int u = 0; u < UB; ++u) { const int iq = i0 + u * stride; ok[u] = iq < n; const int i = ok[u] ? iq : i0; int row = i >> 6; c16v[u] = (i & 63) * 16; if (l == DEPTH - 1) row = (row / SEQ) * LTOK + CTX + row % SEQ; rowv[u] = row;
#pragma unroll
            for (int q = 0; q < 4; ++q) w[u][q] = *(const u32x4*)(G + (size_t)row * 4096 + q * D + c16v[u]); }
#pragma unroll
        for (int u = 0; u < UB; ++u) {
            float a[16];
#pragma unroll
            for (int j = 0; j < 16; ++j) a[j] = 0.f;
#pragma unroll
            for (int q = 0; q < 4; ++q)
#pragma unroll
                for (int k = 0; k < 4; ++k) { const f32x2 lo = __builtin_amdgcn_cvt_pk_f32_fp8((int)w[u][q][k], false), hi = __builtin_amdgcn_cvt_pk_f32_fp8((int)w[u][q][k], true);
                    a[4 * k] += lo[0]; a[4 * k + 1] += lo[1]; a[4 * k + 2] += hi[0]; a[4 * k + 3] += hi[1]; }
            u32x4 o0, o1; constexpr float r = 1.f / G8S;
            o0.x = pk2(a[0] * r, a[1] * r); o0.y = pk2(a[2] * r, a[3] * r); o0.z = pk2(a[4] * r, a[5] * r); o0.w = pk2(a[6] * r, a[7] * r);
            o1.x = pk2(a[8] * r, a[9] * r); o1.y = pk2(a[10] * r, a[11] * r); o1.z = pk2(a[12] * r, a[13] * r); o1.w = pk2(a[14] * r, a[15] * r);
            if (ok[u]) { *(u32x4*)(mx + (size_t)rowv[u] * D + c16v[u]) = o0; *(u32x4*)(mx + (size_t)rowv[u] * D + c16v[u] + 8) = o1; } }
    }
}
DI void split4(const f32x4 v, u32x2& hi, u32x2& lo) {
    hi.x = cvt_pk_bf16(v[0], v[1]); hi.y = cvt_pk_bf16(v[2], v[3]);
    lo.x = cvt_pk_bf16(v[0] - __uint_as_float(hi.x << 16), v[1] - __uint_as_float(hi.x & 0xffff0000u));
    lo.y = cvt_pk_bf16(v[2] - __uint_as_float(hi.y << 16), v[3] - __uint_as_float(hi.y & 0xffff0000u));
}
DI void phase_route(const Ctx& F, int l) {
    constexpr int TT = 24, XROW = 2064, XLO = TT * XROW, POFF = 2 * TT * XROW;
    const int lane = F.lane, wave = F.wave; const bool last = l == DEPTH - 1;
    const float* mod = WSP(float, WS_MOD) + (size_t)l * 9 * 6144;
    const float* gain = GIN(F.in, I_NFFN) + (size_t)l * D;
    int* cnt = WSP(int, WS_CNT) + l * NE; int* amap = WSP(int, WS_AMAP) + (size_t)l * NE * AMAX; float* gateb = WSP(float, WS_GATEB) + (size_t)l * A_TOT;
    LAS int* lcnt = (LAS int*)(F.lds + LDS_MISC); LAS int* lbase = lcnt + 32; LAS int* lst = lcnt + 64;
    constexpr int MAXTOK = 42;
    if (F.tid < 32) lcnt[F.tid] = 0;
    for (int i = F.tid; i < 8 * MAXTOK * 4; i += 512) lst[2 * i + 1] = -1;
    bf16x8 Wh[8], Wl[8];
    { const float* wr = WSP(float, WS_RWT) + (size_t)l * NE * D + (size_t)(lane & 31) * D + 128 * wave + 8 * (lane >> 5);
#pragma unroll
        for (int s = 0; s < 8; ++s) { const f32x4 a = *(const f32x4*)(wr + 16 * s), b = *(const f32x4*)(wr + 16 * s + 4); u32x2 ha, la, hb, lb; split4(a, ha, la); split4(b, hb, lb);
            u32x4 h4; h4.x = ha.x; h4.y = ha.y; h4.z = hb.x; h4.w = hb.y; u32x4 l4; l4.x = la.x; l4.y = la.y; l4.z = lb.x; l4.w = lb.y;
            Wh[s] = __builtin_bit_cast(bf16x8, h4); Wl[s] = __builtin_bit_cast(bf16x8, l4); } }
    const int skip = last ? 240 : 0, per_b = (LTOK - skip) / TT, ntile = NBATCH * per_b;
    u32x2 nx[3][4];
    if (F.bid < ntile) { const int b = F.bid / per_b; const int m0 = b * LTOK + skip + (F.bid - b * per_b) * TT + 3 * wave;
#pragma unroll
        for (int t = 0; t < 3; ++t)
#pragma unroll
            for (int j = 0; j < 4; ++j) nx[t][j] = *(const u32x2*)(WSP(bf16_t, WS_XRES) + (size_t)(m0 + t) * D + 4 * lane + 256 * j); }
    __syncthreads();
    const int myexp = 8 * (lane & 3) + 4 * ((lane >> 4) & 1) + 2 * ((lane >> 3) & 1) + ((lane >> 2) & 1);
    const float mybias = GIN(F.in, I_RB)[l * NE + myexp];
    int tk = 0, mr_c = -1; f32x4 cA[4], cB[4];
#pragma unroll
    for (int j = 0; j < 4; ++j) { cA[j] = (f32x4){0.f, 0.f, 0.f, 0.f}; cB[j] = cA[j]; }
    for (int jt = F.bid; jt < ntile; jt += F.G, tk += 3) {
        int jl = jt; asm volatile("" : "+v"(jl)); jl = __builtin_amdgcn_readfirstlane(jl);
        const int bb = jl / per_b; const int m0 = bb * LTOK + skip + (jl - bb * per_b) * TT + 3 * wave;
        bool live[3];
#pragma unroll
        for (int t = 0; t < 3; ++t) { const int m = m0 + t, pos = m - bb * LTOK, mr = pos < CTX ? 8 : bb;
            live[t] = !(last && pos < CTX);
            float ss = 0.f; f32x4 xv[4];
#pragma unroll
            for (int j = 0; j < 4; ++j) { xv[j] = unpack4(nx[t][j]); ss += xv[j][0] * xv[j][0] + xv[j][1] * xv[j][1] + xv[j][2] * xv[j][2] + xv[j][3] * xv[j][3]; }
            const float rstd = rsqrtf(wave_sum(ss) * (1.f / D) + EPS);
            unsigned char* o = F.ws + WS_HZ + (size_t)m * D;
            LAS unsigned char* xr = F.lds + (3 * wave + t) * XROW + 8 * lane;
            if (mr != mr_c) { mr_c = mr;
#pragma unroll
                for (int j = 0; j < 4; ++j) { const int col = 4 * lane + 256 * j; cA[j] = *(const f32x4*)(gain + col) * (*(const f32x4*)(mod + (size_t)mr * 6144 + 4 * D + col) + 1.f); cB[j] = *(const f32x4*)(mod + (size_t)mr * 6144 + 3 * D + col); } }
#pragma unroll
            for (int j = 0; j < 4; ++j) { const int col = 4 * lane + 256 * j;
                const f32x4 v = xv[j] * rstd * cA[j] + cB[j]; if (live[t]) *(unsigned*)(o + col) = pk4_fp8(v[0], v[1], v[2], v[3]);
                u32x2 hi, lo; split4(v, hi, lo); *(LAS u32x2*)(xr + 512 * j) = hi; *(LAS u32x2*)(xr + XLO + 512 * j) = lo; } }
        { const int jn = jl + F.G;
            if (jn < ntile) { const int b2 = jn / per_b; const int m2 = b2 * LTOK + skip + (jn - b2 * per_b) * TT + 3 * wave;
#pragma unroll
                for (int t = 0; t < 3; ++t)
#pragma unroll
                    for (int j = 0; j < 4; ++j) nx[t][j] = *(const u32x2*)(WSP(bf16_t, WS_XRES) + (size_t)(m2 + t) * D + 4 * lane + 256 * j); } }
        __syncthreads();
        f32x16 acc, acc1, acc2;
#pragma unroll
        for (int i = 0; i < 16; ++i) { acc[i] = 0.f; acc1[i] = 0.f; acc2[i] = 0.f; }
        { const int tn = (lane & 31) < TT ? (lane & 31) : TT - 1;
            const LAS unsigned char* xb = F.lds + tn * XROW + 256 * wave + 16 * (lane >> 5);
#pragma unroll
            for (int s = 0; s < 8; ++s) { const bf16x8 bh = *(const LAS bf16x8*)(xb + 32 * s), bl = *(const LAS bf16x8*)(xb + XLO + 32 * s);
                acc = __builtin_amdgcn_mfma_f32_32x32x16_bf16(Wh[s], bh, acc, 0, 0, 0); acc1 = __builtin_amdgcn_mfma_f32_32x32x16_bf16(Wh[s], bl, acc1, 0, 0, 0); acc2 = __builtin_amdgcn_mfma_f32_32x32x16_bf16(Wl[s], bh, acc2, 0, 0, 0); }
#pragma unroll
            for (int i = 0; i < 16; ++i) acc[i] += acc1[i] + acc2[i]; }
        if ((lane & 31) < TT) { LAS float* pp = (LAS float*)(F.lds + POFF) + wave * (NE * TT) + (lane & 31);
#pragma unroll
            for (int i = 0; i < 16; ++i) pp[((i & 3) + 8 * (i >> 2) + 4 * (lane >> 5)) * TT] = acc[i]; }
        __syncthreads();
#pragma unroll
        for (int t = 0; t < 3; ++t) {
            const LAS float* pr = (const LAS float*)(F.lds + POFF) + myexp * TT + 3 * wave + t;
            float mv = pr[0];
#pragma unroll
            for (int w = 1; w < 8; ++w) mv += pr[w * (NE * TT)];
            mv += mybias;
            const unsigned u0 = __float_as_uint(mv); unsigned key = ((u0 ^ ((unsigned)((int)u0 >> 31) | 0x80000000u)) & ~31u) | (unsigned)(31 - myexp);
            int ti[4]; float tv[4];
#pragma unroll
            for (int k = 0; k < 4; ++k) { unsigned km = key;
                km = max(km, (unsigned)__builtin_amdgcn_update_dpp(km, km, 0xB1, 0xF, 0xF, false)); km = max(km, (unsigned)__builtin_amdgcn_update_dpp(km, km, 0x4E, 0xF, 0xF, false));
                km = max(km, (unsigned)__builtin_amdgcn_update_dpp(km, km, 0x141, 0xF, 0xF, false)); km = max(km, (unsigned)__builtin_amdgcn_update_dpp(km, km, 0x140, 0xF, 0xF, false));
                { const auto r2 = __builtin_amdgcn_permlane16_swap(km, km, false, false); km = max((unsigned)r2[0], (unsigned)r2[1]); }
                ti[k] = 31 - (int)(km & 31u); const unsigned o2 = km & ~31u; tv[k] = __uint_as_float((o2 & 0x80000000u) ? (o2 ^ 0x80000000u) : ~o2); if (myexp == ti[k]) key = 0u; }
            const float e0 = 1.f, e1 = __expf(tv[1] - tv[0]), e2 = __expf(tv[2] - tv[0]), e3 = __expf(tv[3] - tv[0]); const float inv = 1.f / (e0 + e1 + e2 + e3);
            if (lane < 4 && live[t]) { const int m = m0 + t; const int ek = lane == 0 ? ti[0] : lane == 1 ? ti[1] : lane == 2 ? ti[2] : ti[3]; const float gk = (lane == 0 ? e0 : lane == 1 ? e1 : lane == 2 ? e2 : e3) * inv;
                const int lp = __hip_atomic_fetch_add(lcnt + ek, 1, __ATOMIC_RELAXED, __HIP_MEMORY_SCOPE_WORKGROUP);
                const int idx = (wave * MAXTOK + tk + t) * 4 + lane; lst[2 * idx] = ek | (lp << 8); lst[2 * idx + 1] = m * 4 + lane; gateb[(size_t)m * 4 + lane] = gk; }
        }
    }
    __syncthreads();
    if (F.tid < 32) { const int c = lcnt[F.tid]; lbase[F.tid] = c > 0 ? atomicAdd(cnt + F.tid, c) : 0; }
    __syncthreads();
    for (int i = F.tid; i < 8 * MAXTOK * 4; i += 512) { const int a = lst[2 * i + 1]; if (a >= 0) { const int w = lst[2 * i], ek = w & 255, lp = w >> 8; amap[(size_t)ek * AMAX + lbase[ek] + lp] = a; } }
    __syncthreads();
}
DI void moe_prefix(const Ctx& F, int l) {
    LAS int* pref = (LAS int*)(F.lds + LDS_MISC);
    if (F.wave == 0) {
        const int* cnt = WSP(int, WS_CNT) + l * NE; const int lane = F.lane;
        int tiles = lane < NE ? (__hip_atomic_load(cnt + lane, __ATOMIC_RELAXED, __HIP_MEMORY_SCOPE_AGENT) + 255) >> 8 : 0;
        int inc = tiles;
#pragma unroll
        for (int o = 1; o < 64; o <<= 1) { const int t = __shfl_up(inc, o); if (lane >= o) inc += t; }
        if (lane < NE) pref[lane] = inc - tiles;
        if (lane == NE - 1) pref[NE] = inc; }
    __syncthreads();
}
DI void phase_final(const Ctx& F) {
    const int gw = F.bid * 8 + F.wave, NGW = F.G * 8, NQ = NBATCH * SEQ;
    constexpr int UB = 2;
    for (int q0 = gw; q0 < NQ; q0 += UB * NGW) {
        unsigned oraw[UB][4][4]; u32x2 xraw[UB][4]; f32x4 graw[UB], m5v[UB][4]; int qv[UB]; bool ok[UB];
#pragma unroll
        for (int u = 0; u < UB; ++u) { const int qq = q0 + u * NGW; ok[u] = qq < NQ; const int q = ok[u] ? qq : q0; qv[u] = q;
            const int b = q / SEQ, i = q - b * SEQ, m = b * LTOK + CTX + i;
            const unsigned char* ob = F.ws + WS_OBUF + (size_t)m * 4 * D; const bf16_t* xr = WSP(bf16_t, WS_XRES) + (size_t)m * D; const float* m5 = WSP(float, WS_MOD) + ((size_t)9 + b) * 6144 + 5 * D;
            graw[u] = *(const f32x4*)(WSP(float, WS_GATEB) + (size_t)A_TOT + (size_t)m * 4);
#pragma unroll
            for (int j = 0; j < 4; ++j) { const int col = 4 * F.lane + 256 * j; xraw[u][j] = *(const u32x2*)(xr + col); m5v[u][j] = *(const f32x4*)(m5 + col);
#pragma unroll
                for (int k = 0; k < 4; ++k) oraw[u][k][j] = *(const unsigned*)(ob + (size_t)k * D + col); } }
#pragma unroll
        for (int u = 0; u < UB; ++u) {
#pragma unroll
            for (int j = 0; j < 4; ++j) { const int col = 4 * F.lane + 256 * j; f32x4 cv = (f32x4){0.f, 0.f, 0.f, 0.f};
#pragma unroll
                for (int k = 0; k < 4; ++k) { const float g = graw[u][k] * (1.f / O8S); const f32x2 lo = __builtin_amdgcn_cvt_pk_f32_fp8((int)oraw[u][k][j], false), hi = __builtin_amdgcn_cvt_pk_f32_fp8((int)oraw[u][k][j], true);
                    cv[0] += g * lo[0]; cv[1] += g * lo[1]; cv[2] += g * hi[0]; cv[3] += g * hi[1]; }
                if (ok[u]) *(f32x4*)(F.out + (size_t)qv[u] * D + col) = unpack4(xraw[u][j]) + m5v[u][j] * cv; } }
    }
}

#define XB_TMO      128
#define XB_XCNT(j)  (256  + 64 * (j))
#define XB_XSUB(j)  (1280 + 64 * (j))
#define XB_XGEN(j)  (2304 + 64 * (j))
#define XB_TOP      3328
#define XB_TOPGEN   3392
#define XCD_BAR_WORDS 3456
#define XB_SPIN_CAP (1u << 18)
DI unsigned xb_ld(unsigned* p) { return __hip_atomic_load(p, __ATOMIC_RELAXED, __HIP_MEMORY_SCOPE_AGENT); }
DI unsigned xb_add(unsigned* p, unsigned v) { return __hip_atomic_fetch_add(p, v, __ATOMIC_RELAXED, __HIP_MEMORY_SCOPE_AGENT); }
DI unsigned xb_xcc_id() { return (unsigned)__builtin_amdgcn_s_getreg((3 << 11) | 20) & 0xFu; }
#define XB_SPIN(cond, bar) do { unsigned _sp = 0; while (cond) { __builtin_amdgcn_s_sleep(1); \
    if ((++_sp & 255u) == 0u) { if (xb_ld(&(bar)[XB_TMO])) break; if (_sp > XB_SPIN_CAP) { atomicAdd(&(bar)[XB_TMO], 1u); break; } } } } while (0)
struct XcdBarrier { unsigned* bar; unsigned x; volatile LAS unsigned* st; int wid; };
DI XcdBarrier xcd_barrier_post(unsigned* bar, volatile LAS unsigned* st) {
    XcdBarrier b; b.bar = bar; b.x = xb_xcc_id(); b.st = st; b.wid = __builtin_amdgcn_readfirstlane((int)threadIdx.x >> 6);
    if (threadIdx.x == 0) (void)xb_add(&bar[XB_XCNT(b.x)], 1u);
    return b;
}
DI void xcd_barrier_complete(unsigned* bar, unsigned x, unsigned& nloc, unsigned& nx) {
    const unsigned G = gridDim.x * gridDim.y * gridDim.z;
    unsigned sum, cnt, mine, sp = 0u;
    for (;;) {
        sum = 0u; cnt = 0u; mine = 0u;
#pragma unroll
        for (unsigned j = 0; j < 16; ++j) { const unsigned c = xb_ld(&bar[XB_XCNT(j)]); sum += c; cnt += (c > 0u) ? 1u : 0u; mine = (j == x) ? c : mine; }
        if (sum == G) break;
        __builtin_amdgcn_s_sleep(1);
        if ((++sp & 255u) == 0u) { if (xb_ld(&bar[XB_TMO])) break; if (sp > XB_SPIN_CAP) { atomicAdd(&bar[XB_TMO], 1u); break; } }
    }
    nloc = mine > 0u ? mine : 1u; nx = cnt > 0u ? cnt : 1u;
}
DI void xcd_barrier(const XcdBarrier& b) {
    asm volatile("s_waitcnt vmcnt(0)" ::: "memory");
    __syncthreads();
    if (b.wid == 0 && hw_lane() == 0u) {
        unsigned* bar = b.bar;
        __builtin_amdgcn_s_waitcnt(0);
        unsigned nloc = b.st[0], nx = b.st[1];
        if (nloc == 0u) { xcd_barrier_complete(bar, b.x, nloc, nx); b.st[0] = nloc; b.st[1] = nx; }
        const unsigned old = xb_add(&bar[XB_XSUB(b.x)], 1u);
        const unsigned gen = old / nloc;
        if (old + 1u == (gen + 1u) * nloc) {
            __builtin_amdgcn_fence(__ATOMIC_RELEASE, "agent");
            asm volatile("s_waitcnt vmcnt(0)" ::: "memory");
            const unsigned og = xb_add(&bar[XB_TOP], 1u);
            const unsigned tg = og / nx;
            if (og + 1u == (tg + 1u) * nx) xb_add(&bar[XB_TOPGEN], 1u);
            else XB_SPIN(xb_ld(&bar[XB_TOPGEN]) == tg, bar);
            __builtin_amdgcn_fence(__ATOMIC_ACQUIRE, "agent");
            xb_add(&bar[XB_XGEN(b.x)], 1u);
            asm volatile("s_waitcnt vmcnt(0)" ::: "memory");
        } else {
            XB_SPIN(xb_ld(&bar[XB_XGEN(b.x)]) == gen, bar);
            __builtin_amdgcn_fence(__ATOMIC_ACQUIRE, "agent");
            asm volatile("s_waitcnt vmcnt(0)" ::: "memory");
        }
    }
    __syncthreads();
}
constexpr int NSUB = 10;
constexpr int N_PHASES = 1 + NSUB * DEPTH + 1;
#ifndef PHMASK
#define PHMASK 0xFFFFF
#endif
#define PHE(x) ((PHMASK >> (x)) & 1)
#ifndef REPMASK
#define REPMASK 0
#endif
#define NREP(x) (1 + ((REPMASK >> (x)) & 1))
#define PH_LAUNDER { const __attribute__((address_space(4))) cfp_t* pin_ = (const __attribute__((address_space(4))) cfp_t*)__builtin_amdgcn_kernarg_segment_ptr(); __attribute__((address_space(1))) unsigned char* pws_ = (__attribute__((address_space(1))) unsigned char*)P.ws; __attribute__((address_space(1))) float* pout_ = (__attribute__((address_space(1))) float*)P.out; int w_ = xb.wid, l_, g_ = P.G, b_ = blockIdx.x; unsigned lb_ = 0; \
      asm volatile("v_mbcnt_lo_u32_b32 %0, -1, 0\n\tv_mbcnt_hi_u32_b32 %0, -1, %0" : "=v"(l_)); \
      asm volatile("" : "+s"(pin_), "+s"(pws_), "+s"(pout_), "+s"(w_), "+s"(g_), "+s"(b_), "+s"(lb_)); const int t_ = (w_ << 6) | l_; \
      F.in = pin_; F.ws = (unsigned char*)pws_; F.out = (float*)pout_; F.tid = t_; F.lane = t_ & 63; F.wave = w_; F.G = g_; F.bid = b_; F.lds = (LAS unsigned char*)lds_raw + lb_; }
#define RUN_PHASE(k, bit, ...) if (P.ph_lo <= (k) && (k) < P.ph_hi) { if ((k) > P.ph_lo) xcd_barrier(xb); PH_LAUNDER if (PHE(bit)) { const int rep_ = 0; (void)rep_; __VA_ARGS__ } if (NREP(bit) > 1) { const int rep_ = 1; (void)rep_; __syncthreads(); PH_LAUNDER __VA_ARGS__ } }
template <int l> DI void run_layer(const Params& P, Ctx& F, const XcdBarrier& xb, unsigned char* lds_raw) {
    constexpr int base = 1 + NSUB * l;
    RUN_PHASE(base + 0, 0, phase_norm(F, l);)
    RUN_PHASE(base + 1, 1,
        int npass = 1; asm volatile("" : "+s"(npass));
        _Pragma("unroll 1") for (int half = 0; half < npass; ++half) { PH_LAUNDER
          pg8::DenseSched S; S.init(T, 6144, D, D, WSP(bf16_t, WS_W1T) + (size_t)l * NG1 * D, F.G, F.bid);
          pg8::EpiP E{F.ws, F.in, F.lds, l};
          pg8::gemm_phase<false>(F.tid, F.lds, (const char*)WSP(bf16_t, WS_HZ), D, S, E); }
        PH_LAUNDER
        if (l == 0 && F.G == 256) {
          { pg8::DenseSched S; S.init(T, 4096, D / 2, D / 2, F.ws + WS_WMG8 + (size_t)l * 4096 * D, F.G, F.bid, false); S.i1 = 4;
            pg8::EpiGates E{WSP(bf16_t, WS_GATES), GIN(F.in, I_BMG) + (size_t)l * 4096};
            pg8::gemm_phase<true>(F.tid, F.lds, (const char*)(F.ws + WS_HZ8), D / 2, S, E); }
          if (F.bid >= 192) { PH_LAUNDER
            pg8::DenseSched S; S.init(T, 4096, D / 2, D / 2, F.ws + WS_WMG8 + (size_t)l * 4096 * D, 64, F.bid - 192, false); S.i0 = 16; S.i1 = 18;
            pg8::EpiGates E{WSP(bf16_t, WS_GATES), GIN(F.in, I_BMG) + (size_t)l * 4096};
            pg8::gemm_phase<true>(F.tid, F.lds, (const char*)(F.ws + WS_HZ8), D / 2, S, E); }
        } else
        { pg8::DenseSched S; S.init(T, 4096, D / 2, D / 2, F.ws + WS_WMG8 + (size_t)l * 4096 * D, F.G, F.G - 1 - F.bid, l == DEPTH - 1);
          pg8::EpiGates E{WSP(bf16_t, WS_GATES), GIN(F.in, I_BMG) + (size_t)l * 4096};
          pg8::gemm_phase<true>(F.tid, F.lds, (const char*)(F.ws + WS_HZ8), D / 2, S, E); }
)
    RUN_PHASE(base + 2, 2, phase_seqprep(F, l);)
    RUN_PHASE(base + 3, 3, phase_mixers(F, l, rep_);)
    RUN_PHASE(base + 4, 5, pg8::BranchSched S; S.init(l == DEPTH - 1, WSP(bf16_t, WS_WBT) + (size_t)l * 4 * D * 512, F.G, F.bid);
        pg8::EpiBranch E{WSP(bf16_t, WS_GATES), F.ws + WS_P};
        pg8::gemm_phase<false>(F.tid, F.lds, (const char*)WSP(bf16_t, WS_YS), 512, S, E);)
    RUN_PHASE(base + 5, 13, phase_sum4(F, l);)
    RUN_PHASE(base + 6, 6, pg8::DenseSched S; S.init(T, D, D, D, WSP(bf16_t, WS_WOT) + (size_t)l * D * D, F.G, F.bid, l == DEPTH - 1);
        pg8::EpiOut E{GIN(F.in, I_X), GIN(F.in, I_CTX), WSP(bf16_t, WS_XRES), WSP(float, WS_MOD) + (size_t)l * 9 * 6144, l};
        pg8::gemm_phase<false>(F.tid, F.lds, (const char*)WSP(bf16_t, WS_MIXED), D, S, E);)
    RUN_PHASE(base + 7, 7, phase_route(F, l);)
    RUN_PHASE(base + 8, 8, moe_prefix(F, l);
        pg8::MoeSched<8, 2048, true> S{(const LAS int*)(F.lds + LDS_MISC), F.G, F.bid, (const char*)(F.ws + WS_WGU + (size_t)l * NE * 2048 * D), WSP(int, WS_AMAP) + (size_t)l * NE * AMAX};
        pg8::EpiGU E{WSP(int, WS_AMAP) + (size_t)l * NE * AMAX, GIN(F.in, I_BGU) + (size_t)l * NE * 2048, WSP(bf16_t, WS_YBUF)};
        pg8::gemm_phase<true>(F.tid, F.lds, (const char*)WSP(bf16_t, WS_HZ), D / 2, S, E);)
    RUN_PHASE(base + 9, 9, moe_prefix(F, l);
        pg8::MoeSched<4, 1024, false> S{(const LAS int*)(F.lds + LDS_MISC), F.G, F.bid, (const char*)(F.ws + WS_WDN + (size_t)l * NE * D * D), WSP(int, WS_AMAP) + (size_t)l * NE * AMAX};
        pg8::EpiDown E{WSP(int, WS_AMAP) + (size_t)l * NE * AMAX, GIN(F.in, I_BDN) + (size_t)l * NE * D, F.ws + WS_OBUF};
        pg8::gemm_phase<true>(F.tid, F.lds, (const char*)WSP(bf16_t, WS_YBUF), D / 2, S, E);)
}
__global__ void __launch_bounds__(512, 2) fwd_mega(Params P) {
    extern __shared__ __attribute__((aligned(16))) unsigned char lds_raw[];
    Ctx F;
    cg::grid_group grid = cg::this_grid();
    if (P.ph_lo < 0) grid.sync();
    volatile LAS unsigned* bst = (volatile LAS unsigned*)((LAS unsigned char*)lds_raw + LDS_BYTES - 16);
    if (threadIdx.x < 2) bst[threadIdx.x] = 0u;
    __syncthreads();
    const XcdBarrier xb = xcd_barrier_post((unsigned*)(P.ws + WS_BAR), bst);
    RUN_PHASE(0, 10, phase_prep(F);)
    run_layer<0>(P, F, xb, lds_raw);
    run_layer<1>(P, F, xb, lds_raw);
    RUN_PHASE(N_PHASES - 1, 11, phase_final(F);)
}

#ifndef MK_MULTI
#define MK_MULTI 0
#endif
extern "C" void kernel_launch(void* const* d_in, const int* in_sizes, int n_in, void* d_out, int out_size, void* d_ws, size_t ws_size, hipStream_t stream) {
    static int grid = 0;
    if (grid == 0) {
        if (n_in != N_IN || out_size != NBATCH * SEQ * D || ws_size < WS_END) { fprintf(stderr, "kernel_launch: unexpected shapes (n_in %d out %d ws %zu need %zu)\n", n_in, out_size, ws_size, (size_t)WS_END); grid = -1; return; }
        int dev = 0, cus = 0, per_cu = 0;
        (void)hipGetDevice(&dev); (void)hipDeviceGetAttribute(&cus, hipDeviceAttributeMultiprocessorCount, dev);
        if (hipFuncSetAttribute((const void*)fwd_mega, hipFuncAttributeMaxDynamicSharedMemorySize, LDS_BYTES) != hipSuccess) { fprintf(stderr, "kernel_launch: hipFuncSetAttribute failed\n"); grid = -1; return; }
        if (hipOccupancyMaxActiveBlocksPerMultiprocessor(&per_cu, (const void*)fwd_mega, 512, LDS_BYTES) != hipSuccess || per_cu < 1) { fprintf(stderr, "kernel_launch: occupancy query failed (%d)\n", per_cu); (void)hipGetLastError(); per_cu = 1; }
        grid = cus * (per_cu > 1 ? 1 : per_cu);
        fprintf(stderr, "kernel_launch: grid %d (cus %d per_cu %d) ws need %zu have %zu\n", grid, cus, per_cu, (size_t)WS_END, ws_size);
    }
    if (grid < 0) return;
    Params p{};
    for (int i = 0; i < N_IN; ++i) p.in[i] = (const float*)d_in[i];
    p.out = (float*)d_out; p.ws = (unsigned char*)d_ws; p.G = grid; p.pad = 0;
    if (hipMemsetAsync((char*)d_ws + WS_BAR, 0, 16384, stream) != hipSuccess) { fprintf(stderr, "kernel_launch: memset failed\n"); return; }
    p.ph_lo = 0; p.ph_hi = N_PHASES;
    void* args[] = {&p};
    hipError_t e = hipLaunchCooperativeKernel((const void*)fwd_mega, dim3(grid), dim3(512), args, LDS_BYTES, stream);
    if (e != hipSuccess) fprintf(stderr, "kernel_launch: cooperative launch failed: %s (grid %d)\n", hipGetErrorString(e), grid);
}
```
